# Optimizing an MI355X kernel written in HIP

```python
import math
import jax, jax.numpy as jnp
from jax import lax
import numpy as np

D_MODEL = 1024
BATCH = 8
SEQ = 2048
DEPTH = 2
DEC_BATCH = 16
DEC_SEQ = 64
PAST_LEN = 1024

CHUNK = 64
Q_BLOCK = 128
MLA_HEADS = 8
MLA_NOPE = 64
MLA_ROPE = 32
MLA_V = 64
MLA_Q_RANK = 384
MLA_KV_RANK = 256
RET_HEADS = 4
RET_DK = 64
RET_DV = 64
SB_HEADS = 4
SB_DK = 64
SB_DV = 64
MIX_WIDTH = MLA_HEADS * MLA_V + RET_HEADS * RET_DV + SB_HEADS * SB_DV
IN_WIDTHS = (MLA_Q_RANK, MLA_KV_RANK, MLA_ROPE,
             RET_HEADS * RET_DK, RET_HEADS * RET_DK, RET_HEADS * RET_DV, RET_HEADS * RET_DV,
             SB_HEADS * SB_DK, SB_HEADS * SB_DK, SB_HEADS * SB_DV)
IN_COLS = sum(IN_WIDTHS)
D_FF = 2816
CONV_W = 3
ROPE_BASE = 10000.0
EPS = 1e-6

kernel_name = "hybrid_streaming_encoder_step"


def rmsnorm(x, g):
    xf = x.astype(jnp.float32)
    y = xf * lax.rsqrt(jnp.mean(xf * xf, axis=-1, keepdims=True) + EPS)
    return (y * g.astype(jnp.float32)).astype(x.dtype)


def rope(x, pos):
    d = x.shape[-1]
    inv = ROPE_BASE ** (-jnp.arange(0, d, 2, dtype=jnp.float32) / d)
    ang = pos.astype(jnp.float32)[:, None] * inv[None, :]
    ang = ang.reshape((ang.shape[0],) + (1,) * (x.ndim - 3) + (d // 2,))
    cos, sin = jnp.cos(ang), jnp.sin(ang)
    x1 = x[..., : d // 2].astype(jnp.float32)
    x2 = x[..., d // 2:].astype(jnp.float32)
    return jnp.concatenate([x1 * cos - x2 * sin, x1 * sin + x2 * cos], axis=-1).astype(x.dtype)


def sweep_query_blocks(fn, q_args, q_pos):
    nq = q_pos.shape[0]
    if nq <= Q_BLOCK:
        return fn(q_args, q_pos)
    nb = nq // Q_BLOCK

    def one(i):
        s = i * Q_BLOCK
        qa = tuple(lax.dynamic_slice_in_dim(a, s, Q_BLOCK, axis=1) for a in q_args)
        return fn(qa, lax.dynamic_slice_in_dim(q_pos, s, Q_BLOCK))

    out = jnp.moveaxis(lax.map(one, jnp.arange(nb)), 0, 1)
    return out.reshape((out.shape[0], nq) + out.shape[3:])


def _retention_chunk(S, q, k, v):
    L = q.shape[1]
    lg = jnp.log(1.0 - 2.0 ** (-5.0 - jnp.arange(RET_HEADS, dtype=jnp.float32)))
    i = jnp.arange(L, dtype=jnp.float32)
    rel = i[:, None] - i[None, :]
    decay = jnp.where(rel >= 0, jnp.exp(lg[:, None, None] * jnp.maximum(rel, 0.0)), 0.0)
    qf, kf, vf = q.astype(jnp.float32), k.astype(jnp.float32), v.astype(jnp.float32)
    att = jnp.einsum("blhd,bmhd->bhlm", qf, kf) * decay[None]
    o = jnp.einsum("bhlm,bmhe->blhe", att, vf)
    q_decay = jnp.exp(lg[None, :] * (i[:, None] + 1.0))
    o = o + jnp.einsum("blhd,bhde->blhe", qf, S) * q_decay[None, :, :, None]
    k_decay = jnp.exp(lg[None, :] * (L - 1.0 - i[:, None]))
    S_new = jnp.exp(lg * L)[None, :, None, None] * S + jnp.einsum(
        "blhd,blhe->bhde", kf * k_decay[None, :, :, None], vf)
    return S_new, o


def _mixers(h, l, pos0, cache, p):
    B, L, _ = h.shape
    pos = pos0 + jnp.arange(L)
    z = h @ p["w_in"][l]
    splits = [int(s) for s in np.cumsum(IN_WIDTHS)[:-1]]
    zq, zkv, zkr, rq, rk, rv, rg, sq, sk, sv = jnp.split(z, splits, axis=-1)

    q = (rmsnorm(zq, p["g_q_norm"][l]) @ p["w_uq"][l]).reshape(B, L, MLA_HEADS, MLA_NOPE + MLA_ROPE)
    q_nope = q[..., :MLA_NOPE]
    q_rope = rope(q[..., MLA_NOPE:], pos)
    latent = rmsnorm(zkv, p["g_kv_norm"][l])
    k_rope = rope(zkr, pos)
    rq = rope(rq.reshape(B, L, RET_HEADS, RET_DK), pos) * (RET_DK ** -0.5)
    rk = rope(rk.reshape(B, L, RET_HEADS, RET_DK), pos)
    rv = rv.reshape(B, L, RET_HEADS, RET_DV)
    sq = sq.reshape(B, L, SB_HEADS, SB_DK)
    sk = sk.reshape(B, L, SB_HEADS, SB_DK)
    sv = sv.reshape(B, L, SB_HEADS, SB_DV)

    if cache is None:
        lat_all, kr_all, sk_all, sv_all = latent, k_rope, sk, sv
        S0 = jnp.zeros((B, RET_HEADS, RET_DK, RET_DV), jnp.float32)
    else:
        lat_all = jnp.concatenate([cache["lat"].astype(latent.dtype), latent], axis=1)
        kr_all = jnp.concatenate([cache["kr"].astype(k_rope.dtype), k_rope], axis=1)
        sk_all = jnp.concatenate([cache["sk"].astype(sk.dtype), sk], axis=1)
        sv_all = jnp.concatenate([cache["sv"].astype(sv.dtype), sv], axis=1)
        S0 = cache["S"].astype(jnp.float32)
    k_pos = jnp.arange(lat_all.shape[1])

    kv = (lat_all @ p["w_ukv"][l]).reshape(B, -1, MLA_HEADS, MLA_NOPE + MLA_V)
    k_nope, v_mla = kv[..., :MLA_NOPE], kv[..., MLA_NOPE:]
    mla_scale = (MLA_NOPE + MLA_ROPE) ** -0.5

    def mla_fn(qa, qp):
        qn, qr = qa
        s = (jnp.einsum("bqhd,bkhd->bhqk", qn, k_nope) + jnp.einsum("bqhd,bkd->bhqk", qr, kr_all)).astype(jnp.float32) * mla_scale
        mask = (k_pos[None, :] // CHUNK) <= (qp[:, None] // CHUNK)
        s = jnp.where(mask, s, -1e30)
        w = jax.nn.softmax(s, axis=-1).astype(v_mla.dtype)
        return jnp.einsum("bhqk,bkhd->bqhd", w, v_mla)

    mla_out = sweep_query_blocks(mla_fn, (q_nope, q_rope), pos).reshape(B, L, MLA_HEADS * MLA_V)

    if cache is None:
        n = L // CHUNK
        def to_chunks(a):
            return jnp.swapaxes(a.reshape((B, n, CHUNK) + a.shape[2:]), 0, 1)
        def step(S, inp):
            return _retention_chunk(S, *inp)
        S_new, ro = lax.scan(step, S0, (to_chunks(rq), to_chunks(rk), to_chunks(rv)))
        ro = jnp.swapaxes(ro, 0, 1).reshape(B, L, RET_HEADS, RET_DV)
    else:
        S_new, ro = _retention_chunk(S0, rq, rk, rv)
    mu = jnp.mean(ro, axis=-1, keepdims=True)
    var = jnp.mean((ro - mu) ** 2, axis=-1, keepdims=True)
    ro = ((ro - mu) * lax.rsqrt(var + EPS)).reshape(B, L, RET_HEADS * RET_DV) * p["g_ret_norm"][l].astype(jnp.float32)
    ret_out = (jax.nn.silu(rg.astype(jnp.float32)) * ro).astype(h.dtype)

    sb_scale = SB_DK ** -0.5

    def sb_fn(qa, qp):
        (qs,) = qa
        zz = jnp.einsum("bqhd,bkhd->bhqk", qs, sk_all).astype(jnp.float32) * sb_scale
        mask = k_pos[None, :] < qp[:, None]
        log_beta = jax.nn.log_sigmoid(zz)
        log_1mb = jnp.where(mask, log_beta - zz, 0.0)
        after = lax.cumsum(log_1mb, axis=3, reverse=True) - log_1mb
        w = jnp.where(mask, jnp.exp(log_beta + after), 0.0).astype(sv_all.dtype)
        return jnp.einsum("bhqk,bkhd->bqhd", w, sv_all)

    sb_out = sweep_query_blocks(sb_fn, (sq,), pos).reshape(B, L, SB_HEADS * SB_DV)

    mix = jnp.concatenate([mla_out, ret_out, sb_out], axis=-1) @ p["w_o"][l]
    return mix, (latent, k_rope, sk, sv, S_new.astype(h.dtype))


def _conv_ffn(h, prev, l, p):
    L = h.shape[1]
    up = h @ p["w_up"][l]
    a, b = up[..., :D_FF], up[..., D_FF:]
    a_ext = jnp.concatenate([prev.astype(a.dtype), a], axis=1)
    w = p["conv_w"][l]
    conv = p["conv_b"][l] + w[0] * a_ext[:, 0:L]
    for j in range(1, CONV_W):
        conv = conv + w[j] * a_ext[:, j:j + L]
    y = (jax.nn.silu(conv) * b) @ p["w_down"][l]
    return y, a_ext[:, -(CONV_W - 1):]


def _trunk(x, c, pos0, cache, p):
    new = [[] for _ in range(6)]
    B = x.shape[0]
    for l in range(DEPTH):
        mod = (jax.nn.silu(c) @ p["w_ada"][l] + p["b_ada"][l])[:, None, :]
        sh1, sc1, g1, sh2, sc2, g2 = jnp.split(mod, 6, axis=-1)
        lc = None if cache is None else {k: v[l] for k, v in cache.items()}
        h = rmsnorm(x, p["g_norm1"][l]) * (1.0 + sc1) + sh1
        mix, st = _mixers(h, l, pos0, lc, p)
        x = x + g1 * mix
        h = rmsnorm(x, p["g_norm2"][l]) * (1.0 + sc2) + sh2
        prev = jnp.zeros((B, CONV_W - 1, D_FF), x.dtype) if lc is None else lc["conv"]
        f, buf = _conv_ffn(h, prev, l, p)
        x = x + g2 * f
        for lst, s in zip(new, st + (buf,)):
            lst.append(s)
    y = rmsnorm(x, p["g_final"])
    return y, [jnp.stack(s, axis=0) for s in new]


def setup_inputs(seed: int = 0) -> dict:
    key = jax.random.key(seed)
    ks = jax.random.split(key, 32)
    nrm = jax.random.normal
    f32 = jnp.float32
    return {
        "x_prompt": nrm(ks[0], (BATCH, SEQ, D_MODEL), f32),
        "x_sample": nrm(ks[1], (DEC_BATCH, DEC_SEQ, D_MODEL), f32),
        "c_prompt": nrm(ks[2], (BATCH, D_MODEL), f32),
        "c_sample": nrm(ks[3], (DEC_BATCH, D_MODEL), f32),
        "cache_mla_latent": nrm(ks[4], (DEPTH, DEC_BATCH, PAST_LEN, MLA_KV_RANK), f32),
        "cache_mla_krope": nrm(ks[5], (DEPTH, DEC_BATCH, PAST_LEN, MLA_ROPE), f32),
        "cache_sb_k": nrm(ks[6], (DEPTH, DEC_BATCH, PAST_LEN, SB_HEADS, SB_DK), f32),
        "cache_sb_v": nrm(ks[7], (DEPTH, DEC_BATCH, PAST_LEN, SB_HEADS, SB_DV), f32),
        "state_ret": 2.0 * nrm(ks[8], (DEPTH, DEC_BATCH, RET_HEADS, RET_DK, RET_DV), f32),
        "state_ffn_conv": nrm(ks[9], (DEPTH, DEC_BATCH, CONV_W - 1, D_FF), f32),
        "w_in": nrm(ks[10], (DEPTH, D_MODEL, IN_COLS), f32) * D_MODEL ** -0.5,
        "g_q_norm": 1.0 + 0.02 * nrm(ks[11], (DEPTH, MLA_Q_RANK), f32),
        "w_uq": nrm(ks[12], (DEPTH, MLA_Q_RANK, MLA_HEADS * (MLA_NOPE + MLA_ROPE)), f32) * MLA_Q_RANK ** -0.5,
        "g_kv_norm": 1.0 + 0.02 * nrm(ks[13], (DEPTH, MLA_KV_RANK), f32),
        "w_ukv": nrm(ks[14], (DEPTH, MLA_KV_RANK, MLA_HEADS * (MLA_NOPE + MLA_V)), f32) * MLA_KV_RANK ** -0.5,
        "g_ret_norm": 1.0 + 0.02 * nrm(ks[15], (DEPTH, RET_HEADS * RET_DV), f32),
        "w_o": nrm(ks[16], (DEPTH, MIX_WIDTH, D_MODEL), f32) * MIX_WIDTH ** -0.5,
        "w_up": nrm(ks[17], (DEPTH, D_MODEL, 2 * D_FF), f32) * D_MODEL ** -0.5,
        "conv_w": nrm(ks[18], (DEPTH, CONV_W, D_FF), f32) * CONV_W ** -0.5,
        "conv_b": 0.02 * nrm(ks[19], (DEPTH, D_FF), f32),
        "w_down": nrm(ks[20], (DEPTH, D_FF, D_MODEL), f32) * D_FF ** -0.5,
        "g_norm1": 1.0 + 0.02 * nrm(ks[21], (DEPTH, D_MODEL), f32),
        "g_norm2": 1.0 + 0.02 * nrm(ks[22], (DEPTH, D_MODEL), f32),
        "w_ada": nrm(ks[23], (DEPTH, D_MODEL, 6 * D_MODEL), f32) * (0.5 * D_MODEL ** -0.5),
        "b_ada": 0.02 * nrm(ks[24], (DEPTH, 6 * D_MODEL), f32),
        "g_final": 1.0 + 0.02 * nrm(ks[25], (D_MODEL,), f32),
    }


def reference(x_prompt, x_sample, c_prompt, c_sample, cache_mla_latent, cache_mla_krope, cache_sb_k, cache_sb_v,
              state_ret, state_ffn_conv, w_in, g_q_norm, w_uq, g_kv_norm, w_ukv, g_ret_norm, w_o, w_up, conv_w,
              conv_b, w_down, g_norm1, g_norm2, w_ada, b_ada, g_final):
    p = dict(w_in=w_in, g_q_norm=g_q_norm, w_uq=w_uq, g_kv_norm=g_kv_norm, w_ukv=w_ukv, g_ret_norm=g_ret_norm,
             w_o=w_o, w_up=w_up, conv_w=conv_w, conv_b=conv_b, w_down=w_down, g_norm1=g_norm1, g_norm2=g_norm2,
             w_ada=w_ada, b_ada=b_ada, g_final=g_final)
    y_prompt, (p_lat, p_kr, p_sk, p_sv, p_S, p_conv) = _trunk(x_prompt, c_prompt, 0, None, p)
    cache = dict(lat=cache_mla_latent, kr=cache_mla_krope, sk=cache_sb_k, sv=cache_sb_v, S=state_ret,
                 conv=state_ffn_conv)
    y_sample, (s_lat, s_kr, s_sk, s_sv, s_S, s_conv) = _trunk(x_sample, c_sample, PAST_LEN, cache, p)
    return (y_prompt, y_sample, p_lat, p_kr, p_sk, p_sv, p_S, p_conv, s_lat, s_kr, s_sk, s_sv, s_S, s_conv)
```

```cpp
#include <hip/hip_runtime.h>
#include <hip/hip_cooperative_groups.h>
#include <cstdio>
#include <cstdint>
namespace cg = cooperative_groups;

#ifndef GEMM_ALIGN
#define GEMM_ALIGN true
#endif
#ifndef GEMM_SP2
#define GEMM_SP2 true
#endif
#ifndef RET_PAR
#define RET_PAR 0
#endif
#define DI __device__ __forceinline__
#define LAS __attribute__((address_space(3)))
#define GAS __attribute__((address_space(1)))
typedef unsigned short bf16_t;
typedef short bf16x8 __attribute__((ext_vector_type(8)));
typedef short s16x4 __attribute__((ext_vector_type(4)));
typedef float f32x4 __attribute__((ext_vector_type(4)));
typedef float f32x2 __attribute__((ext_vector_type(2)));
typedef float f32x16 __attribute__((ext_vector_type(16)));
typedef unsigned u32x4 __attribute__((ext_vector_type(4)));
typedef unsigned u32x2 __attribute__((ext_vector_type(2)));
typedef __bf16 bf16x2_t __attribute__((ext_vector_type(2)));

constexpr int MP = 16384, MS = 1024, MT = MP + MS, DM = 1024, KVS = 1088, KVR = MP + 16 * KVS, DFF = 2816;
constexpr int NIN = 2560, NUP = 5632;
constexpr float EPS = 1e-6f, LOG2E = 1.4426950408889634f, LN2 = 0.6931471805599453f;

constexpr size_t O_YP = 0, O_YS = O_YP + (size_t)MP * DM, O_PLAT = O_YS + (size_t)MS * DM, O_PKR = O_PLAT + (size_t)2 * MP * 256,
    O_PSK = O_PKR + (size_t)2 * MP * 32, O_PSV = O_PSK + (size_t)2 * MP * 256, O_PS = O_PSV + (size_t)2 * MP * 256,
    O_PCONV = O_PS + (size_t)2 * 8 * 4 * 64 * 64, O_SLAT = O_PCONV + (size_t)2 * 8 * 2 * DFF, O_SKR = O_SLAT + (size_t)2 * MS * 256,
    O_SSK = O_SKR + (size_t)2 * MS * 32, O_SSV = O_SSK + (size_t)2 * MS * 256, O_SS = O_SSV + (size_t)2 * MS * 256,
    O_SCONV = O_SS + (size_t)2 * 16 * 4 * 64 * 64, O_END = O_SCONV + (size_t)2 * 16 * 2 * DFF;

constexpr size_t al(size_t x) { return (x + 255) & ~(size_t)255; }
constexpr size_t WS_CTL = 0;
constexpr size_t WS_MOD = 16384;
constexpr size_t WS_CV1 = al(WS_MOD + (size_t)2 * 24 * 6144 * 4);
constexpr size_t WS_CV2 = al(WS_CV1 + (size_t)2 * 24 * NIN * 4);
constexpr size_t WS_SHM = al(WS_CV2 + (size_t)2 * 24 * NUP * 4);
constexpr size_t WS_SSQ = al(WS_SHM + (size_t)256 * 1024 * 2);
constexpr size_t WS_SSQQ = al(WS_SSQ + (size_t)MT * 16 * 4);
constexpr size_t WS_SSQKV = al(WS_SSQQ + (size_t)MT * 8 * 4);
constexpr size_t WS_W = al(WS_SSQKV + (size_t)MT * 4 * 4);
constexpr size_t W_IN = 0, W_UQ = W_IN + (size_t)NIN * 1024 * 2, W_UKVG = W_UQ + (size_t)768 * 384 * 2, W_UKV = W_UKVG + (size_t)1024 * 256 * 2,
    W_O = W_UKV + (size_t)1024 * 256 * 2, W_UP = W_O + (size_t)1024 * 1024 * 2, W_DN = W_UP + (size_t)NUP * 1024 * 2, W_LAYER = W_DN + (size_t)1024 * DFF * 2;
constexpr size_t WS_CLB = al(WS_W + 2 * W_LAYER);
constexpr size_t WS_U = al(WS_CLB + (size_t)2 * 16384 * 256 * 2);
constexpr size_t U_ZQ = 0, U_ZKV = al(U_ZQ + (size_t)MT * 384 * 2), U_KR = al(U_ZKV + (size_t)MT * 256 * 2), U_SK = al(U_KR + (size_t)KVR * 32 * 2),
    U_SV = al(U_SK + (size_t)KVR * 256 * 2), U_RQ = al(U_SV + (size_t)KVR * 256 * 2), U_RK = al(U_RQ + (size_t)MT * 256 * 2), U_RV = al(U_RK + (size_t)MT * 256 * 2),
    U_RG = al(U_RV + (size_t)MT * 256 * 2), U_SQ = al(U_RG + (size_t)MT * 256 * 2), U_MIX = al(U_SQ + (size_t)MT * 256 * 2), U_QN = al(U_MIX + (size_t)MT * 1024 * 2),
    U_QR = al(U_QN + (size_t)MT * 512 * 2), U_KN = al(U_QR + (size_t)MT * 256 * 2), U_VM = al(U_KN + (size_t)KVR * 512 * 2), U_ATT_END = al(U_VM + (size_t)KVR * 512 * 2);
constexpr size_t U_A = 0, U_B = al(U_A + (size_t)MT * DFF * 2), U_FFN_END = al(U_B + (size_t)MT * DFF * 2);
constexpr size_t U_AP = U_FFN_END > U_QN ? U_FFN_END : U_QN;
constexpr size_t U_AP_END = U_AP + (size_t)MT * 1024 * 2;
static_assert(U_AP >= U_QN && U_AP >= U_FFN_END, "AP placement");
constexpr size_t U_UC = al(U_AP_END > U_ATT_END ? U_AP_END : U_ATT_END);
constexpr size_t WS_END = WS_U + U_UC + (size_t)1024 * 4096 * 4;

constexpr int LDS_BYTES = 147456;
constexpr int LDS_MISC = 147456 - 64;

struct Params {
    const float* in[26];
    float* out;
    unsigned char* ws;
};
enum { I_XP = 0, I_XS, I_CP, I_CS, I_CLAT, I_CKR, I_CSK, I_CSV, I_SRET, I_SCONV, I_WIN, I_GQ, I_WUQ, I_GKV, I_WUKV, I_GRET, I_WO, I_WUP, I_CONVW, I_CONVB,
       I_WDN, I_GN1, I_GN2, I_WADA, I_BADA, I_GFIN };

DI unsigned pk2(float lo, float hi) { f32x2 v = {lo, hi}; bf16x2_t b = __builtin_convertvector(v, bf16x2_t); return __builtin_bit_cast(unsigned, b); }
DI float bf2f(unsigned short b) { return __builtin_bit_cast(float, (unsigned)b << 16); }
DI float bflo(unsigned u) { return __builtin_bit_cast(float, u << 16); }
DI float bfhi(unsigned u) { return __builtin_bit_cast(float, u & 0xffff0000u); }
DI u32x4 pack8(const float* v) { u32x4 w; w.x = pk2(v[0], v[1]); w.y = pk2(v[2], v[3]); w.z = pk2(v[4], v[5]); w.w = pk2(v[6], v[7]); return w; }
DI u32x2 pack4(const float* v) { u32x2 w; w.x = pk2(v[0], v[1]); w.y = pk2(v[2], v[3]); return w; }
DI float ex2(float x) { return __builtin_amdgcn_exp2f(x); }
DI float lg2(float x) { return __builtin_amdgcn_logf(x); }
DI float silu(float x) { return x * __builtin_amdgcn_rcpf(1.f + ex2(-x * LOG2E)); }
DI void sincos_rev(float ang, float& s, float& c) { float rev = ang * 0.15915494309189535f; rev = __builtin_amdgcn_fractf(rev); s = __builtin_amdgcn_sinf(rev); c = __builtin_amdgcn_cosf(rev); }
DI void row_info(int row, int& mb, int& pos, int& kvrow) {
    if (row < MP) { mb = row >> 11; pos = row & 2047; kvrow = row; }
    else { const int r = row - MP, b = r >> 6, t = r & 63; mb = 8 + b; pos = 1024 + t; kvrow = MP + b * KVS + 1024 + t; }
}
DI float* orow(float* out, int l, int row, size_t poff, size_t soff, int W) {
    return row < MP ? out + poff + ((size_t)l * MP + row) * W : out + soff + ((size_t)l * MS + (row - MP)) * W;
}
DI float sum16(const float* p) { const f32x4* q = (const f32x4*)p; f32x4 a = q[0], b = q[1], c = q[2], d = q[3]; f32x4 s = (a + b) + (c + d); return (s[0] + s[1]) + (s[2] + s[3]); }
DI float sum8(const float* p) { const f32x4* q = (const f32x4*)p; f32x4 s = q[0] + q[1]; return (s[0] + s[1]) + (s[2] + s[3]); }
DI float sum4(const float* p) { const f32x4 s = *(const f32x4*)p; return (s[0] + s[1]) + (s[2] + s[3]); }
DI float shx(float v, int lane, int m) { return __builtin_bit_cast(float, __builtin_amdgcn_ds_bpermute((lane ^ m) << 2, __builtin_bit_cast(int, v))); }
#define xor16_32(s) xor16_32_l((s), fr + 16 * fq)
DI float xor16_32_l(float s, int lane) { s += shx(s, lane, 16); s += shx(s, lane, 32); return s; }
DI int otid_w(int wave) { int lane; asm volatile("v_mbcnt_lo_u32_b32 %0, -1, 0\n\tv_mbcnt_hi_u32_b32 %0, -1, %0" : "=v"(lane)); asm volatile("" : "+s"(wave)); return wave * 64 + lane; }
#define otid() otid_w(g_wave)
template <class T> DI T* osp(T* p) { GAS T* g = (GAS T*)p; asm volatile("" : "+s"(g)); return (T*)g; }
template <class T> DI T* gptr(T* p) { return p; }
DI int osi(int v) { asm volatile("" : "+s"(v)); return v; }
DI int crow(int i, int h) { return (i & 3) + 8 * (i >> 2) + 4 * h; }
#define LBAR() do { asm volatile("s_waitcnt lgkmcnt(0)" ::: "memory"); __builtin_amdgcn_s_barrier(); asm volatile("" ::: "memory"); } while (0)
#define MFMA32(a, b, c) __builtin_amdgcn_mfma_f32_32x32x16_bf16((a), (b), (c), 0, 0, 0)
typedef short v4i16_t __attribute__((ext_vector_type(4)));
DI s16x4 trr(LAS const unsigned char* p) { return __builtin_bit_cast(s16x4, __builtin_amdgcn_ds_read_tr16_b64_v4i16((LAS v4i16_t*)p)); }
DI bf16x8 tr_frag(LAS const unsigned char* p, int hi_off) { s16x4 lo = trr(p), hi = trr(p + hi_off); return __builtin_shufflevector(lo, hi, 0, 1, 2, 3, 4, 5, 6, 7); }
DI bf16x8 packfrag(const f32x16& x, int s) {
    u32x4 w; w.x = pk2(x[8 * s], x[8 * s + 1]); w.y = pk2(x[8 * s + 2], x[8 * s + 3]); w.z = pk2(x[8 * s + 4], x[8 * s + 5]); w.w = pk2(x[8 * s + 6], x[8 * s + 7]);
    return __builtin_bit_cast(bf16x8, w);
}

namespace pg8 {
constexpr int BM = 256, BK = 64, HALF = 128, HTB = HALF * BK * 2, STAGE_BYTES = 8 * HTB, NXCD = 8, WGM = 8;
DI int lds_byte(int r, int c) { const int st = (r >> 4) * 2 + (c >> 5), rr = r & 15, cc = c & 31, ob = rr * 64 + cc * 2; return st * 1024 + (ob ^ (((ob >> 9) & 1) << 5)); }
DI void stage_rc(int b, int& R, int& C) { const int st = b / 1024, sb = b % 1024, swz = sb ^ (((sb >> 9) & 1) << 5); R = (st >> 1) * 16 + swz / 64; C = (st & 1) * 32 + (swz % 64) / 2; }
DI int perm32(int rho) { const int n = rho >> 4, i = rho & 15; return 8 * (i >> 2) + 4 * n + (i & 3); }
struct Unit { int pm, pn; };
struct Gemm { const bf16_t* A; const bf16_t* Bt; int M, N, K; };
struct StaticOrder {
    int nM, nN, nwg, G, c, pm0, Llo, Lhi;
    DI void init(int M, int N, int G_, int c_) { nM = M / BM; nN = N / BM; nwg = nM * nN; G = G_; c = c_; pm0 = 0; Llo = 0; Lhi = nwg; }
    DI bool next(int i, Unit& u) const {
        int cc = c; asm volatile("" : "+s"(cc)); const long L = (long)Llo + (long)i * G + cc; if (L >= Lhi) return false;
        int wgid = (int)L; { const int q = nwg / NXCD, r = nwg % NXCD, xcd = wgid % NXCD, off = wgid / NXCD; wgid = (xcd < r ? xcd * (q + 1) : r * (q + 1) + (xcd - r) * q) + off; }
        const int nig = WGM * nN, gid = wgid / nig, fm = gid * WGM, gsz = (nM - fm) < WGM ? (nM - fm) : WGM;
        u.pm = pm0 + fm + ((wgid % nig) % gsz); u.pn = (wgid % nig) / gsz; return true;
    }
};

template <class Epi, bool ALIGN_EPI, bool SP2>
DI void gemm_phase(int g_wave, LAS unsigned char* lds, const Gemm g, const StaticOrder& S, const Epi& E) {
    const int tid = otid(), wid = __builtin_amdgcn_readfirstlane(tid >> 6), lane = tid & 63, wr = wid >> 2, wc = wid & 3, fr = lane & 15, fq = lane >> 4;
    const int K = g.K, nt = K / BK;
    unsigned voffA[2], voffB[2];
#pragma unroll
    for (int i = 0; i < 2; ++i) { int R, C; stage_rc(tid * 16 + i * 8192, R, C); const int Rb = (R & ~31) + perm32(R & 31);
        voffA[i] = (unsigned)(R * K + C) * 2u; voffB[i] = (unsigned)(Rb * K + C) * 2u; }
    const size_t kstep = (size_t)(BK * 2);
    const size_t hstep = (size_t)HALF * K * 2;
    const size_t tstep = 2 * hstep;
    const unsigned ldsw = (unsigned)wid * 1024u;
    const int aoff = lds_byte(wr * 64 + fr, fq * 8), boff = lds_byte(wc * 32 + fr, fq * 8);
#define PG8_SA(b, h) (((b) * 2 + (h)) * HTB)
#define PG8_SB(b, h) ((4 + (b) * 2 + (h)) * HTB)
#define PG8_STAGE(bufoff, gbase, voff) do { _Pragma("unroll") for (int _i = 0; _i < 2; ++_i) \
        __builtin_amdgcn_global_load_lds((const unsigned*)((const char*)(gbase) + (voff)[_i]), (LAS unsigned*)(lds + (bufoff) + ldsw + _i * 8192), 16, 0, 0); } while (0)
#define PG8_LDA(dst, b, h) do { _Pragma("unroll") for (int m = 0; m < 4; ++m) _Pragma("unroll") for (int k = 0; k < 2; ++k) dst[m][k] = *(const LAS bf16x8*)(lds + PG8_SA(b, h) + aoff + m * 2048 + k * 1024); } while (0)
#define PG8_LDB(dst, b, h) do { _Pragma("unroll") for (int n = 0; n < 2; ++n) _Pragma("unroll") for (int k = 0; k < 2; ++k) dst[n][k] = *(const LAS bf16x8*)(lds + PG8_SB(b, h) + boff + n * 2048 + k * 1024); } while (0)
#define PG8_MMA(ai, bj, At, Bt) do { __builtin_amdgcn_s_setprio(1); _Pragma("unroll") for (int m = 0; m < 4; ++m) _Pragma("unroll") for (int n = 0; n < 2; ++n) _Pragma("unroll") for (int k = 0; k < 2; ++k) \
        acc[ai][bj][m][n] = __builtin_amdgcn_mfma_f32_16x16x32_bf16(Bt[n][k], At[m][k], acc[ai][bj][m][n], 0, 0, 0); __builtin_amdgcn_s_setprio(0); } while (0)
#define PG8_WAIT_V(n) asm volatile("s_waitcnt vmcnt(" #n ")" ::: "memory")
#define PG8_WAIT_L(n) asm volatile("s_waitcnt lgkmcnt(" #n ")" ::: "memory")
#define PG8_BAR __builtin_amdgcn_s_barrier()
#define PG8_SCHED __builtin_amdgcn_sched_barrier(0)
    Unit cur, nxt; int ui = 0;
    if (!S.next(0, cur)) return;
    f32x4 acc[2][2][4][2];
#pragma unroll
    for (int a = 0; a < 2; ++a)
#pragma unroll
        for (int b = 0; b < 2; ++b)
#pragma unroll
            for (int m = 0; m < 4; ++m)
#pragma unroll
                for (int n = 0; n < 2; ++n) acc[a][b][m][n] = (f32x4){0.f, 0.f, 0.f, 0.f};
    bf16x8 At[4][2], B0[2][2], B1[2][2];
    const char* cA = (const char*)g.A + (size_t)cur.pm * tstep; const char* cB = (const char*)g.Bt + (size_t)cur.pn * tstep;
    if constexpr (SP2) {
        PG8_STAGE(PG8_SB(0, 0), cB, voffB); PG8_STAGE(PG8_SB(0, 1), cB + hstep, voffB); PG8_STAGE(PG8_SA(0, 0), cA, voffA); PG8_STAGE(PG8_SA(0, 1), cA + hstep, voffA);
        if (wr == 1) PG8_BAR;
        PG8_WAIT_V(2); PG8_BAR;
        PG8_STAGE(PG8_SB(1, 0), cB + kstep, voffB); PG8_STAGE(PG8_SA(1, 0), cA + kstep, voffA); PG8_STAGE(PG8_SB(1, 1), cB + hstep + kstep, voffB);
        PG8_WAIT_V(6); PG8_BAR;
    } else {
    PG8_STAGE(PG8_SB(0, 0), cB, voffB); PG8_STAGE(PG8_SA(0, 0), cA, voffA); PG8_STAGE(PG8_SB(0, 1), cB + hstep, voffB); PG8_STAGE(PG8_SA(0, 1), cA + hstep, voffA);
    if (wr == 1) PG8_BAR;
    PG8_WAIT_V(4); PG8_BAR;
    PG8_STAGE(PG8_SB(1, 0), cB + kstep, voffB); PG8_STAGE(PG8_SA(1, 0), cA + kstep, voffA); PG8_STAGE(PG8_SB(1, 1), cB + hstep + kstep, voffB);
    PG8_WAIT_V(6); PG8_BAR;
    }
    for (;;) {
        const bool has_next = S.next(ui + 1, nxt);
        const char* nA = has_next ? (const char*)g.A + (size_t)nxt.pm * tstep : cA; const char* nB = has_next ? (const char*)g.Bt + (size_t)nxt.pn * tstep : cB;
        for (int t = 0; t < nt; t += 2) {
            const bool last = (t == nt - 2);
            const char* a1 = cA + (size_t)(t + 1) * kstep;
            const char* a2 = last ? nA : cA + (size_t)(t + 2) * kstep; const char* b2 = last ? nB : cB + (size_t)(t + 2) * kstep;
            const char* a3 = a2 + kstep; const char* b3 = b2 + kstep;
            if constexpr (SP2) {
            PG8_LDB(B0, 0, 0); PG8_LDB(B1, 0, 1); PG8_SCHED; PG8_LDA(At, 0, 0); PG8_STAGE(PG8_SA(1, 1), a1 + hstep, voffA);
            PG8_WAIT_V(8); PG8_WAIT_L(0); PG8_BAR; PG8_MMA(0, 0, At, B0); PG8_MMA(0, 1, At, B1); PG8_BAR; PG8_SCHED;
            PG8_LDA(At, 0, 1); PG8_STAGE(PG8_SB(0, 0), b2, voffB); PG8_STAGE(PG8_SB(0, 1), b2 + hstep, voffB); PG8_STAGE(PG8_SA(0, 0), a2, voffA);
            PG8_WAIT_V(8); PG8_WAIT_L(0); PG8_BAR; PG8_MMA(1, 0, At, B0); PG8_MMA(1, 1, At, B1); PG8_BAR; PG8_SCHED;
            PG8_LDB(B0, 1, 0); PG8_LDB(B1, 1, 1); PG8_SCHED; PG8_LDA(At, 1, 0); PG8_STAGE(PG8_SA(0, 1), a2 + hstep, voffA);
            PG8_WAIT_V(8); PG8_WAIT_L(0); PG8_BAR; PG8_MMA(0, 0, At, B0); PG8_MMA(0, 1, At, B1); PG8_BAR; PG8_SCHED;
            PG8_LDA(At, 1, 1); PG8_STAGE(PG8_SB(1, 0), b3, voffB); PG8_STAGE(PG8_SB(1, 1), b3 + hstep, voffB); PG8_STAGE(PG8_SA(1, 0), a3, voffA);
            PG8_WAIT_V(8); PG8_WAIT_L(0); PG8_BAR; PG8_MMA(1, 0, At, B0); PG8_MMA(1, 1, At, B1); PG8_BAR; PG8_SCHED;

            } else {
            PG8_LDB(B0, 0, 0); PG8_SCHED; PG8_LDA(At, 0, 0); PG8_STAGE(PG8_SA(1, 1), a1 + hstep, voffA);
            PG8_WAIT_L(8); PG8_BAR; PG8_WAIT_L(0); PG8_MMA(0, 0, At, B0); PG8_BAR; PG8_SCHED;
            PG8_LDB(B1, 0, 1); PG8_STAGE(PG8_SB(0, 0), b2, voffB);
            PG8_BAR; PG8_WAIT_L(0); PG8_MMA(0, 1, At, B1); PG8_BAR;
            PG8_LDA(At, 0, 1); PG8_STAGE(PG8_SA(0, 0), a2, voffA);
            PG8_BAR; PG8_WAIT_L(0); PG8_MMA(1, 0, At, B0); PG8_BAR; PG8_SCHED;
            PG8_STAGE(PG8_SB(0, 1), b2 + hstep, voffB);
            PG8_WAIT_V(6); PG8_BAR; PG8_MMA(1, 1, At, B1); PG8_BAR;
            PG8_LDB(B0, 1, 0); PG8_SCHED; PG8_LDA(At, 1, 0); PG8_STAGE(PG8_SA(0, 1), a2 + hstep, voffA);
            PG8_WAIT_L(8); PG8_BAR; PG8_WAIT_L(0); PG8_MMA(0, 0, At, B0); PG8_BAR; PG8_SCHED;
            PG8_LDB(B1, 1, 1); PG8_STAGE(PG8_SB(1, 0), b3, voffB);
            PG8_BAR; PG8_WAIT_L(0); PG8_MMA(0, 1, At, B1); PG8_BAR;
            PG8_LDA(At, 1, 1); PG8_STAGE(PG8_SA(1, 0), a3, voffA);
            PG8_BAR; PG8_WAIT_L(0); PG8_MMA(1, 0, At, B0); PG8_BAR; PG8_SCHED;
            PG8_STAGE(PG8_SB(1, 1), b3 + hstep, voffB);
            PG8_WAIT_V(6); PG8_BAR; PG8_MMA(1, 1, At, B1); PG8_BAR;
            }
        }
        if constexpr (ALIGN_EPI) { if (wr == 0) PG8_BAR; }
        { const int t2_ = otid(); int fr_ = t2_ & 15, fq_ = (t2_ >> 4) & 3, wr_ = wr, wc_ = wc; asm volatile("" : "+v"(fr_), "+v"(fq_), "+s"(wr_), "+s"(wc_)); E(acc, cur, wr_, wc_, fr_, fq_); }
        if (!has_next) break;
#pragma unroll
        for (int a = 0; a < 2; ++a)
#pragma unroll
            for (int b = 0; b < 2; ++b)
#pragma unroll
                for (int m = 0; m < 4; ++m)
#pragma unroll
                    for (int n = 0; n < 2; ++n) acc[a][b][m][n] = (f32x4){0.f, 0.f, 0.f, 0.f};
        cur = nxt; cA = nA; cB = nB; ++ui;
        if constexpr (ALIGN_EPI) { if (wr == 1) PG8_BAR; }
    }
    PG8_WAIT_V(0);
    if constexpr (!ALIGN_EPI) { if (wr == 0) PG8_BAR; }
    PG8_BAR;
#undef PG8_SA
#undef PG8_SB
#undef PG8_STAGE
#undef PG8_LDA
#undef PG8_LDB
#undef PG8_MMA
#undef PG8_WAIT_V
#undef PG8_WAIT_L
#undef PG8_BAR
#undef PG8_SCHED
}
}
using pg8::Unit;
typedef const f32x4 (&AccRef)[2][2][4][2];

template <class Epi>
DI void run_gemm_w(int g_wave, LAS unsigned char* lds, const bf16_t* A, const bf16_t* Bt, int M, int N, int K, int rot, const Epi& E) {
    pg8::Gemm g; g.A = A; g.Bt = Bt; g.M = M; g.N = N; g.K = K;
    pg8::StaticOrder S; S.init(M, N, gridDim.x, (int)((blockIdx.x + (unsigned)rot) % gridDim.x));
    pg8::gemm_phase<Epi, GEMM_ALIGN, GEMM_SP2>(g_wave, lds, g, S, E);
}

template <class Epi>
DI void run_gemm_sub(int g_wave, LAS unsigned char* lds, const bf16_t* A, const bf16_t* Bt, int M, int N, int K, int pm0, int Gs, int cs, const Epi& E) {
    pg8::Gemm g; g.A = A; g.Bt = Bt; g.M = M; g.N = N; g.K = K;
    pg8::StaticOrder S; S.init(M, N, Gs, cs); S.pm0 = pm0;
    pg8::gemm_phase<Epi, GEMM_ALIGN, GEMM_SP2>(g_wave, lds, g, S, E);
}

template <class Epi>
DI void run_gemm_win(int g_wave, LAS unsigned char* lds, const bf16_t* A, const bf16_t* Bt, int M, int N, int K, int pm0, int Gs, int cs, int lo, int hi, const Epi& E) {
    pg8::Gemm g; g.A = A; g.Bt = Bt; g.M = M; g.N = N; g.K = K;
    pg8::StaticOrder S; S.init(M, N, Gs, cs); S.pm0 = pm0; S.Llo = lo; S.Lhi = hi;
    pg8::gemm_phase<Epi, GEMM_ALIGN, GEMM_SP2>(g_wave, lds, g, S, E);
}

constexpr float KEXP32 = 13.287712379549449f / 16.f, KEXP64 = 13.287712379549449f / 32.f;

struct EpiC {
    float* dst; int r0, ldc;
    DI void operator()(AccRef acc, const Unit& u, int wr, int wc, int fr, int fq) const {
#pragma unroll
        for (int ai = 0; ai < 2; ++ai)
#pragma unroll
            for (int m = 0; m < 4; ++m) {
                const int row = ai * 128 + wr * 64 + 16 * m + fr - r0;
                if (row >= 0 && row < 24) {
#pragma unroll
                    for (int bj = 0; bj < 2; ++bj)
#pragma unroll
                        for (int n = 0; n < 2; ++n) *(f32x4*)(dst + (size_t)row * ldc + u.pn * 256 + bj * 128 + wc * 32 + fq * 8 + 4 * n) = acc[ai][bj][m][n];
                }
            }
    }
};

struct EpiIn {
    int l; unsigned char* ws; float* out; const float* gkv; LAS unsigned char* xl;
    template <int PN> DI void body(AccRef acc, const Unit& u, int wr, int wc, int fr, int fq) const {
        const int cl = wc * 32 + fq * 8;
        unsigned char* U = ws + WS_U;
        const float* ssq = (const float*)(ws + WS_SSQ); const float* cv = (const float*)(ws + WS_CV1) + (size_t)l * 24 * NIN;
        bf16_t *zq = (bf16_t*)(U + U_ZQ), *zkv = (bf16_t*)(U + U_ZKV), *kr = (bf16_t*)(U + U_KR), *sk = (bf16_t*)(U + U_SK), *sv = (bf16_t*)(U + U_SV), *rq = (bf16_t*)(U + U_RQ),
               *rk = (bf16_t*)(U + U_RK), *rv = (bf16_t*)(U + U_RV), *rg = (bf16_t*)(U + U_RG), *sq = (bf16_t*)(U + U_SQ);
        float *ssqq = (float*)(ws + WS_SSQQ), *ssqkv = (float*)(ws + WS_SSQKV);
        (void)zq; (void)zkv; (void)kr; (void)sk; (void)sv; (void)rq; (void)rk; (void)rv; (void)rg; (void)sq; (void)ssqq; (void)ssqkv;
        float rinvh[2][4];
        f32x4 cvh[2][2][2];
        int zdep = 0;
#pragma unroll
        for (int ai = 0; ai < 2; ++ai) {
            const int rb_ = u.pm * 256 + ai * 128 + wr * 64 + fr;
#pragma unroll
            for (int m = 0; m < 4; ++m) rinvh[ai][m] = rsqrtf(sum16(ssq + (size_t)(rb_ + 16 * m + zdep) * 16) * (1.f / 1024.f) + EPS);
            asm volatile("v_mov_b32 %0, 0" : "=v"(zdep) : "v"(rinvh[ai][0]), "v"(rinvh[ai][1]), "v"(rinvh[ai][2]), "v"(rinvh[ai][3]));
        }
#pragma unroll
        for (int ai = 0; ai < 2; ++ai) {
            const int rb_ = u.pm * 256 + ai * 128 + wr * 64 + fr;
            int mb_, p_, k_; row_info(rb_, mb_, p_, k_);
#pragma unroll
            for (int bj = 0; bj < 2; ++bj)
#pragma unroll
                for (int n = 0; n < 2; ++n) cvh[ai][bj][n] = *(const f32x4*)(cv + (size_t)(mb_ + zdep) * NIN + PN * 256 + bj * 128 + cl + 4 * n);
        }
#pragma unroll
        for (int ai = 0; ai < 2; ++ai) {
            const int rb = u.pm * 256 + ai * 128 + wr * 64 + fr;
            int mb, pos0, kv0; row_info(rb, mb, pos0, kv0);
#pragma unroll
            for (int m = 0; m < 4; ++m) {
                const int row = rb + 16 * m, pos = pos0 + 16 * m, kvrow = kv0 + 16 * m;
                const float rinv = rinvh[ai][m];
                float v[2][8];
#pragma unroll
                for (int bj = 0; bj < 2; ++bj)
#pragma unroll
                    for (int n = 0; n < 2; ++n)
#pragma unroll
                        for (int j = 0; j < 4; ++j) v[bj][4 * n + j] = acc[ai][bj][m][n][j] * rinv + cvh[ai][bj][n][j];
                if constexpr (PN == 0) {
                    float s = 0.f;
#pragma unroll
                    for (int bj = 0; bj < 2; ++bj) {
                        *(u32x4*)(zkv + (size_t)row * 256 + bj * 128 + cl) = pack8(v[bj]);
#pragma unroll
                        for (int j = 0; j < 8; ++j) s += v[bj][j] * v[bj][j];
                    }
                    s = xor16_32(s);
                    if (fq == 0) { ssqkv[(size_t)row * 4 + wc] = s; *(LAS float*)(xl + ((ai * 128 + wr * 64 + 16 * m + fr) * 4 + wc) * 4) = s; }
                } else if constexpr (PN == 1) {
                    float s = 0.f;
#pragma unroll
                    for (int bj = 0; bj < 2; ++bj) {
                        *(u32x4*)(zq + (size_t)row * 384 + bj * 128 + cl) = pack8(v[bj]);
#pragma unroll
                        for (int j = 0; j < 8; ++j) s += v[bj][j] * v[bj][j];
                    }
                    s = xor16_32(s);
                    if (fq == 0) ssqq[(size_t)row * 8 + wc] = s;
                } else if constexpr (PN == 2) {
                    float s = 0.f;
                    *(u32x4*)(zq + (size_t)row * 384 + 256 + cl) = pack8(v[0]);
#pragma unroll
                    for (int j = 0; j < 8; ++j) s += v[0][j] * v[0][j];
                    s = xor16_32(s);
                    if (fq == 0) ssqq[(size_t)row * 8 + 4 + wc] = s;
                    if (wc == 0) {
                        float o1[4], o2[4];
#pragma unroll
                        for (int j = 0; j < 4; ++j) { const int i = 4 * fq + j; float sn, cs; sincos_rev((float)pos * ex2(-(float)i * KEXP32), sn, cs);
                            o1[j] = v[1][j] * cs - v[1][4 + j] * sn; o2[j] = v[1][j] * sn + v[1][4 + j] * cs; }
                        float* ko = orow(out, l, row, O_PKR, O_SKR, 32);
                        *(f32x4*)(ko + 4 * fq) = (f32x4){o1[0], o1[1], o1[2], o1[3]};
                        *(f32x4*)(ko + 16 + 4 * fq) = (f32x4){o2[0], o2[1], o2[2], o2[3]};
                        *(u32x2*)(kr + (size_t)kvrow * 32 + 4 * fq) = pack4(o1);
                        *(u32x2*)(kr + (size_t)kvrow * 32 + 16 + 4 * fq) = pack4(o2);
                    }
                } else if constexpr (PN == 3 || PN == 4) {
                    bf16_t* dst = PN == 3 ? rq : rk;
                    const float sc = PN == 3 ? 0.125f : 1.f;
#pragma unroll
                    for (int bj = 0; bj < 2; ++bj) {
                        const int head = 2 * bj + (wc >> 1), i0 = 16 * (wc & 1) + 4 * fq;
                        float o1[4], o2[4];
#pragma unroll
                        for (int j = 0; j < 4; ++j) { float sn, cs; sincos_rev((float)pos * ex2(-(float)(i0 + j) * KEXP64), sn, cs);
                            o1[j] = (v[bj][j] * cs - v[bj][4 + j] * sn) * sc; o2[j] = (v[bj][j] * sn + v[bj][4 + j] * cs) * sc; }
                        *(u32x2*)(dst + (size_t)row * 256 + head * 64 + i0) = pack4(o1);
                        *(u32x2*)(dst + (size_t)row * 256 + head * 64 + 32 + i0) = pack4(o2);
                    }
                } else if constexpr (PN == 5 || PN == 6 || PN == 7) {
                    bf16_t* dst = PN == 5 ? rv : (PN == 6 ? rg : sq);
#pragma unroll
                    for (int bj = 0; bj < 2; ++bj) {
                        if constexpr (PN == 6) {
#pragma unroll
                            for (int j = 0; j < 8; ++j) v[bj][j] = silu(v[bj][j]);
                        }
                        if constexpr (PN == 7) {
#pragma unroll
                            for (int j = 0; j < 8; ++j) v[bj][j] *= 0.125f;
                        }
                        *(u32x4*)(dst + (size_t)row * 256 + bj * 128 + cl) = pack8(v[bj]);
                    }
                } else {
                    float* lo = orow(out, l, row, PN == 8 ? O_PSK : O_PSV, PN == 8 ? O_SSK : O_SSV, 256);
#pragma unroll
                    for (int bj = 0; bj < 2; ++bj) {
                        *(f32x4*)(lo + bj * 128 + cl) = (f32x4){v[bj][0], v[bj][1], v[bj][2], v[bj][3]};
                        *(f32x4*)(lo + bj * 128 + cl + 4) = (f32x4){v[bj][4], v[bj][5], v[bj][6], v[bj][7]};
                    }
                }
            }
        }
        if constexpr (PN == 0) {
            static_assert(GEMM_ALIGN, "the exchange uses a workgroup barrier: both half-workgroups must be in the epilogue together");
            asm volatile("s_waitcnt lgkmcnt(0)" ::: "memory"); __builtin_amdgcn_s_barrier(); asm volatile("" ::: "memory");
            f32x4 gk[2][2];
#pragma unroll
            for (int bj = 0; bj < 2; ++bj)
#pragma unroll
                for (int n = 0; n < 2; ++n) gk[bj][n] = *(const f32x4*)(gkv + bj * 128 + cl + 4 * n);
#pragma unroll
            for (int ai = 0; ai < 2; ++ai) {
                const int rb = u.pm * 256 + ai * 128 + wr * 64 + fr;
#pragma unroll
                for (int m = 0; m < 4; ++m) {
                    const int row = rb + 16 * m;
                    const f32x4 pp = *(LAS const f32x4*)(xl + (ai * 128 + wr * 64 + 16 * m + fr) * 16);
                    const float rk = rsqrtf(((pp[0] + pp[1]) + (pp[2] + pp[3])) * (1.f / 256.f) + EPS);
                    float* lo = orow(out, l, row, O_PLAT, O_SLAT, 256);
#pragma unroll
                    for (int bj = 0; bj < 2; ++bj)
#pragma unroll
                        for (int n = 0; n < 2; ++n) {
                            const f32x4 vv = (acc[ai][bj][m][n] * rinvh[ai][m] + cvh[ai][bj][n]) * gk[bj][n] * rk;
                            *(f32x4*)(lo + bj * 128 + cl + 4 * n) = vv;
                        }
                }
            }
        }
    }
    DI void operator()(AccRef acc, const Unit& u, int wr, int wc, int fr, int fq) const {
        switch (u.pn) {
            case 0: body<0>(acc, u, wr, wc, fr, fq); break;
            case 1: body<1>(acc, u, wr, wc, fr, fq); break;
            case 2: body<2>(acc, u, wr, wc, fr, fq); break;
            case 3: body<3>(acc, u, wr, wc, fr, fq); break;
            case 4: body<4>(acc, u, wr, wc, fr, fq); break;
            case 5: body<5>(acc, u, wr, wc, fr, fq); break;
            case 6: body<6>(acc, u, wr, wc, fr, fq); break;
            case 7: body<7>(acc, u, wr, wc, fr, fq); break;
            case 8: body<8>(acc, u, wr, wc, fr, fq); break;
            default: body<9>(acc, u, wr, wc, fr, fq); break;
        }
    }
};

struct EpiQ {
    unsigned char* ws;
    DI void operator()(AccRef acc, const Unit& u, int wr, int wc, int fr, int fq) const {
        const int cl = wc * 32 + fq * 8;
        const float* ssqq = (const float*)(ws + WS_SSQQ); bf16_t *qn = (bf16_t*)(ws + WS_U + U_QN), *qr = (bf16_t*)(ws + WS_U + U_QR);
        const float qs = 0.10206207261596575f * LOG2E;
        float rinvh[2][4];
        int zdep = 0;
#pragma unroll
        for (int ai = 0; ai < 2; ++ai) {
#pragma unroll
            for (int m = 0; m < 4; ++m) rinvh[ai][m] = rsqrtf(sum8(ssqq + (size_t)(u.pm * 256 + ai * 128 + wr * 64 + fr + 16 * m + zdep) * 8) * (1.f / 384.f) + EPS) * qs;
            asm volatile("v_mov_b32 %0, 0" : "=v"(zdep) : "v"(rinvh[ai][0]), "v"(rinvh[ai][1]), "v"(rinvh[ai][2]), "v"(rinvh[ai][3]));
        }
#pragma unroll
        for (int ai = 0; ai < 2; ++ai) {
            const int rb = u.pm * 256 + ai * 128 + wr * 64 + fr;
            int mb, pos0, kv0; row_info(rb, mb, pos0, kv0);
#pragma unroll
            for (int m = 0; m < 4; ++m) {
                const int row = rb + 16 * m, pos = pos0 + 16 * m;
                const float rinv = rinvh[ai][m];
#pragma unroll
                for (int bj = 0; bj < 2; ++bj) {
                    float v[8];
#pragma unroll
                    for (int n = 0; n < 2; ++n)
#pragma unroll
                        for (int j = 0; j < 4; ++j) v[4 * n + j] = acc[ai][bj][m][n][j] * rinv;
                    if (u.pn < 2) {
                        *(u32x4*)(qn + (size_t)row * 512 + u.pn * 256 + bj * 128 + cl) = pack8(v);
                    } else {
                        const int head = 4 * bj + wc;
                        float o1[4], o2[4];
#pragma unroll
                        for (int j = 0; j < 4; ++j) { const int i = 4 * fq + j; float sn, cs; sincos_rev((float)pos * ex2(-(float)i * KEXP32), sn, cs);
                            o1[j] = v[j] * cs - v[4 + j] * sn; o2[j] = v[j] * sn + v[4 + j] * cs; }
                        *(u32x2*)(qr + (size_t)row * 256 + head * 32 + 4 * fq) = pack4(o1);
                        *(u32x2*)(qr + (size_t)row * 256 + head * 32 + 16 + 4 * fq) = pack4(o2);
                    }
                }
            }
        }
    }
};

struct EpiKV {
    int mode; unsigned char* ws;
    DI void operator()(AccRef acc, const Unit& u, int wr, int wc, int fr, int fq) const {
        const int cl = wc * 32 + fq * 8;
        const float* ssqkv = (const float*)(ws + WS_SSQKV); bf16_t *kn = (bf16_t*)(ws + WS_U + U_KN), *vm = (bf16_t*)(ws + WS_U + U_VM);
        bf16_t* dst = u.pn < 2 ? kn : vm;
        const int cb = (u.pn & 1) * 256;
        float rinvh[2][4];
#pragma unroll
        for (int ai = 0; ai < 2; ++ai)
#pragma unroll
            for (int m = 0; m < 4; ++m) rinvh[ai][m] = mode == 0 ? rsqrtf(sum4(ssqkv + (size_t)(u.pm * 256 + ai * 128 + wr * 64 + fr + 16 * m) * 4) * (1.f / 256.f) + EPS) : 1.f;
#pragma unroll
        for (int ai = 0; ai < 2; ++ai) {
            const int rb = u.pm * 256 + ai * 128 + wr * 64 + fr;
#pragma unroll
            for (int m = 0; m < 4; ++m) {
                const int row = rb + 16 * m;
                int kvrow; const float rinv = rinvh[ai][m];
                if (mode == 0) { int mb, pos; row_info(row, mb, pos, kvrow); }
                else { kvrow = MP + (row >> 10) * KVS + (row & 1023); }
#pragma unroll
                for (int bj = 0; bj < 2; ++bj) {
                    float v[8];
#pragma unroll
                    for (int n = 0; n < 2; ++n)
#pragma unroll
                        for (int j = 0; j < 4; ++j) v[4 * n + j] = acc[ai][bj][m][n][j] * rinv;
                    *(u32x4*)(dst + (size_t)kvrow * 512 + cb + bj * 128 + cl) = pack8(v);
                }
            }
        }
    }
};

struct EpiRes {
    const float* xin_p; const float* xin_s;
    float* xout; unsigned char* ws; int gate_off, scn_off, has_ap;
    const float* gn;
    DI void operator()(AccRef acc, const Unit& u, int wr, int wc, int fr, int fq) const {
        const int cl = wc * 32 + fq * 8;
        const float* gate = (const float*)(ws + WS_MOD) + gate_off; const float* scn = (const float*)(ws + WS_MOD) + scn_off;
        bf16_t* ap = has_ap ? (bf16_t*)(ws + WS_U + U_AP) : nullptr; float* ssq = (float*)(ws + WS_SSQ);
#pragma unroll
        for (int ai = 0; ai < 2; ++ai) {
            const int rb = u.pm * 256 + ai * 128 + wr * 64 + fr;
            int mb, pos0, kv0; row_info(rb, mb, pos0, kv0);
            f32x4 gt[2][2], gs[2][2];
#pragma unroll
            for (int bj = 0; bj < 2; ++bj)
#pragma unroll
                for (int n = 0; n < 2; ++n) {
                    const int c = u.pn * 256 + bj * 128 + cl + 4 * n;
                    gt[bj][n] = *(const f32x4*)(gate + (size_t)mb * 6144 + c);
                    if (ap) { const f32x4 g = *(const f32x4*)(gn + c), s = *(const f32x4*)(scn + (size_t)mb * 6144 + c); gs[bj][n] = g * (s + 1.f); }
                }
#pragma unroll
            for (int m = 0; m < 4; ++m) {
                const int row = rb + 16 * m;
                const float* xi = row < MP ? xin_p + (size_t)row * 1024 : xin_s + (size_t)(row - MP) * 1024;
                float s = 0.f;
#pragma unroll
                for (int bj = 0; bj < 2; ++bj) {
                    const int c = u.pn * 256 + bj * 128 + cl;
                    float v[8];
#pragma unroll
                    for (int n = 0; n < 2; ++n) {
                        const f32x4 x = *(const f32x4*)(xi + c + 4 * n);
                        const f32x4 y = x + gt[bj][n] * acc[ai][bj][m][n];
                        *(f32x4*)(xout + (size_t)row * 1024 + c + 4 * n) = y;
#pragma unroll
                        for (int j = 0; j < 4; ++j) { s += y[j] * y[j]; v[4 * n + j] = ap ? y[j] * gs[bj][n][j] : 0.f; }
                    }
                    if (ap) *(u32x4*)(ap + (size_t)row * 1024 + c) = pack8(v);
                }
                s = xor16_32(s);
                if (fq == 0) ssq[(size_t)row * 16 + u.pn * 4 + wc] = s;
            }
        }
    }
};

constexpr size_t U_HA = 0, U_HB = al(U_HA + (size_t)(MT / 64) * 2 * DFF * 4), U_TA = al(U_HB + (size_t)(MT / 64) * 2 * DFF * 4), U_SIDE_END = al(U_TA + (size_t)(MT / 64) * 2 * DFF * 4);
static_assert(U_SIDE_END <= U_B, "side buffers must not reach the gated buffer");
template <int CTRL> DI float dppf(float x) { return __builtin_bit_cast(float, __builtin_amdgcn_update_dpp(0, __builtin_bit_cast(int, x), CTRL, 0xf, 0xf, false)); }

DI f32x4 ldg4(const void* base, unsigned off) { return *(const GAS f32x4*)((const GAS char*)base + off); }
DI void stg4(void* base, unsigned off, f32x4 v) { *(GAS f32x4*)((GAS char*)base + off) = v; }
struct EpiUp {
    int l; unsigned char* ws; float* out; const float* convw; const float* convb; const float* sconv;
    DI void operator()(AccRef acc, const Unit& u, int wr, int wc, int fr, int fq) const {
        const int cl = wc * 32 + fq * 8;
        const unsigned clb = (unsigned)cl * 4u;
        const float* ssq = (const float*)(ws + WS_SSQ);
        bf16_t* b_ = (bf16_t*)(ws + WS_U + U_B);
        const int pnu = __builtin_amdgcn_readfirstlane(u.pn);
        const float* cwt = convw + (size_t)l * 3 * DFF + pnu * 128; const float* cbt = convb + (size_t)l * DFF + pnu * 128;
#pragma unroll
        for (int ai = 0; ai < 2; ++ai) {
            const int G64 = __builtin_amdgcn_readfirstlane(u.pm * 4 + ai * 2 + wr);
            const int rb0 = G64 * 64;
            const bool samp = rb0 >= MP;
            const int mb = samp ? 8 + ((rb0 - MP) >> 6) : (rb0 >> 11);
            const bool seqstart = samp || ((G64 & 31) == 0);
            const bool seqend = samp || ((G64 & 31) == 31);
            const float* cvt = (const float*)(ws + WS_CV2) + ((size_t)l * 24 + mb) * NUP + pnu * 256;
            const float* stt = sconv + ((size_t)(l * 16 + (samp ? G64 - MP / 64 : 0)) * 2) * DFF + pnu * 128;
            float* hat = (float*)(ws + WS_U + U_HA) + ((size_t)G64 * 2) * DFF + pnu * 128;
            float* hbt = (float*)(ws + WS_U + U_HB) + ((size_t)G64 * 2) * DFF + pnu * 128;
            float* tat = (float*)(ws + WS_U + U_TA) + ((size_t)G64 * 2) * DFF + pnu * 128;
            float* cot = (samp ? out + O_SCONV + ((size_t)(l * 16 + (G64 - MP / 64)) * 2) * DFF : out + O_PCONV + ((size_t)(l * 8 + (G64 >> 5)) * 2) * DFF) + pnu * 128;
            const unsigned rowb = (unsigned)(rb0 + fr);
            float rinv[4];
#pragma unroll
            for (int m = 0; m < 4; ++m) rinv[m] = rsqrtf(sum16((const float*)((const char*)ssq + (rowb + 16u * m) * 64u)) * (1.f / 1024.f) + EPS);
            const unsigned bo = (rowb * (unsigned)DFF + (unsigned)(pnu * 128 + cl)) * 2u;
#pragma unroll
            for (int n = 0; n < 2; ++n) {
                const unsigned co = clb + 16u * n;
                const f32x4 cva = ldg4(cvt, co), cvb = ldg4(cvt, co + 512u);
                const f32x4 w0 = ldg4(cwt, co), w1 = ldg4(cwt, co + (unsigned)DFF * 4u), w2 = ldg4(cwt, co + (unsigned)DFF * 8u), cb = ldg4(cbt, co);
                f32x4 h1 = (f32x4){0.f, 0.f, 0.f, 0.f}, h2 = h1;
                if (samp) { h2 = ldg4(stt, co); h1 = ldg4(stt, co + (unsigned)DFF * 4u); }
                f32x4 a[4];
#pragma unroll
                for (int m = 0; m < 4; ++m) a[m] = acc[ai][0][m][n] * rinv[m] + cva;
#pragma unroll
                for (int m = 0; m < 4; ++m) {
                    const f32x4 bv = acc[ai][1][m][n] * rinv[m] + cvb;
                    float gt[4];
#pragma unroll
                    for (int j = 0; j < 4; ++j) {
                        const float r1c = dppf<0x121>(a[m][j]), r2c = dppf<0x122>(a[m][j]);
                        float r1p, r2p;
                        if (m == 0) { r1p = h1[j]; r2p = fr == 0 ? h2[j] : h1[j]; }
                        else { r1p = dppf<0x121>(a[m - 1][j]); r2p = dppf<0x122>(a[m - 1][j]); }
                        const float p1 = fr == 0 ? r1p : r1c, p2 = fr < 2 ? r2p : r2c;
                        const float cvv = cb[j] + w0[j] * p2 + w1[j] * p1 + w2[j] * a[m][j];
                        gt[j] = silu(cvv) * bv[j];
                    }
                    if (m == 0 && fr < 2 && !seqstart) { stg4(hat, (unsigned)fr * (unsigned)DFF * 4u + co, a[0]); stg4(hbt, (unsigned)fr * (unsigned)DFF * 4u + co, bv); }
                    else *(u32x2*)((char*)b_ + bo + (unsigned)(16 * m) * (unsigned)DFF * 2u + 8u * n) = pack4(gt);
                }
                if (fr >= 14) {
                    stg4(tat, (unsigned)(fr - 14) * (unsigned)DFF * 4u + co, a[3]);
                    if (seqend) stg4(cot, (unsigned)(fr - 14) * (unsigned)DFF * 4u + co, a[3]);
                }
                asm volatile("" ::: "memory");
            }
        }
    }
};

DI void mla_item(int g_wave, LAS unsigned char* lds, const bf16_t* QN, const bf16_t* QR, const bf16_t* KN, const bf16_t* KRb, const bf16_t* VM, bf16_t* MIX,
                 int kvbase, int qrow0, int nq, int head, int ntiles, int wt) {
    const int tid = otid(), w = __builtin_amdgcn_readfirstlane(tid >> 6), lane = tid & 63, r = lane & 31, h = lane >> 5;
    constexpr int KST = 208, VST = 144, KB = 64 * KST, BUF = KB + 64 * VST;
    const bool active = 32 * w < nq;
    bf16x8 qf[6];
    {
        const int row = qrow0 + (active ? 32 * w + r : r);
#pragma unroll
        for (int s = 0; s < 4; ++s) qf[s] = *(const bf16x8*)(QN + (size_t)row * 512 + head * 64 + 16 * s + 8 * h);
#pragma unroll
        for (int s = 0; s < 2; ++s) qf[4 + s] = *(const bf16x8*)(QR + (size_t)row * 256 + head * 32 + 16 * s + 8 * h);
    }
    const int lk = tid >> 3, lc = tid & 7, rkk = (tid & 255) >> 2, rc = tid & 3;
    u32x4 gk, gv, gr;
#define MLA_LOAD(T) do { const size_t kr_ = (size_t)(kvbase + 64 * (T)); \
        gk = *(const u32x4*)(KN + (kr_ + lk) * 512 + head * 64 + lc * 8); gv = *(const u32x4*)(VM + (kr_ + lk) * 512 + head * 64 + lc * 8); \
        if (tid < 256) gr = *(const u32x4*)(KRb + (kr_ + rkk) * 32 + rc * 8); } while (0)
#define MLA_STORE(bi) do { LAS unsigned char* b_ = lds + (bi) * BUF; *(LAS u32x4*)(b_ + lk * KST + lc * 16) = gk; *(LAS u32x4*)(b_ + KB + lk * VST + lc * 16) = gv; \
        if (tid < 256) *(LAS u32x4*)(b_ + rkk * KST + 128 + rc * 16) = gr; } while (0)
    MLA_LOAD(0); MLA_STORE(0);
    __syncthreads();
    float m_run = -1e30f, l_run = 0.f;
    f32x16 o0, o1;
#pragma unroll
    for (int i = 0; i < 16; ++i) { o0[i] = 0.f; o1[i] = 0.f; }
    const int i16 = lane & 15, tq = i16 >> 2, tp = i16 & 3, blk = (lane >> 4) & 1;
    for (int T = 0; T < ntiles; ++T) {
        if (T + 1 < ntiles) MLA_LOAD(T + 1);
        if (T < wt) {
            LAS const unsigned char* base = lds + (T & 1) * BUF;
            f32x16 s0, s1;
#pragma unroll
            for (int i = 0; i < 16; ++i) { s0[i] = 0.f; s1[i] = 0.f; }
#pragma unroll
            for (int s = 0; s < 6; ++s) {
                const bf16x8 a0 = *(LAS const bf16x8*)(base + r * KST + (16 * s + 8 * h) * 2);
                const bf16x8 a1 = *(LAS const bf16x8*)(base + (32 + r) * KST + (16 * s + 8 * h) * 2);
                s0 = MFMA32(a0, qf[s], s0); s1 = MFMA32(a1, qf[s], s1);
            }
            float mx = s0[0];
#pragma unroll
            for (int i = 0; i < 16; ++i) { mx = fmaxf(mx, s0[i]); mx = fmaxf(mx, s1[i]); }
            mx = fmaxf(mx, shx(mx, lane, 32));
            const float m_new = fmaxf(m_run, mx), alpha = ex2(m_run - m_new);
            m_run = m_new;
            float ls = 0.f;
#pragma unroll
            for (int i = 0; i < 16; ++i) { s0[i] = ex2(s0[i] - m_new); s1[i] = ex2(s1[i] - m_new); ls += s0[i] + s1[i]; }
            l_run = l_run * alpha + ls;
#pragma unroll
            for (int i = 0; i < 16; ++i) { o0[i] *= alpha; o1[i] *= alpha; }
            LAS const unsigned char* vb = base + KB;
#pragma unroll
            for (int kt = 0; kt < 2; ++kt)
#pragma unroll
                for (int ss = 0; ss < 2; ++ss) {
                    const bf16x8 pb = packfrag(kt == 0 ? s0 : s1, ss);
                    LAS const unsigned char* vp = vb + (32 * kt + 16 * ss + 4 * h + tq) * VST + (16 * blk + 4 * tp) * 2;
                    const bf16x8 a0 = tr_frag(vp, 8 * VST), a1 = tr_frag(vp + 64, 8 * VST);
                    o0 = MFMA32(a0, pb, o0); o1 = MFMA32(a1, pb, o1);
                }
        }
        if (T + 1 < ntiles) MLA_STORE((T + 1) & 1);
        LBAR();
    }
#undef MLA_LOAD
#undef MLA_STORE
    if (active) {
        const float lt = l_run + shx(l_run, lane, 32), inv = 1.f / lt;
        bf16_t* orow_ = MIX + (size_t)(qrow0 + 32 * w + r) * 1024 + head * 64;
#pragma unroll
        for (int g = 0; g < 4; ++g) {
            float a[4], b[4];
#pragma unroll
            for (int j = 0; j < 4; ++j) { a[j] = o0[4 * g + j] * inv; b[j] = o1[4 * g + j] * inv; }
            *(u32x2*)(orow_ + 8 * g + 4 * h) = pack4(a);
            *(u32x2*)(orow_ + 32 + 8 * g + 4 * h) = pack4(b);
        }
    }
}

DI void sb_item(int g_wave, LAS unsigned char* lds, const bf16_t* SQ, const float* kf, const float* vf, bf16_t* MIX, int kvbase, int qrow0, int qpos0, int nq, int head,
                const float* ck, const float* cvp) {
    const int tid = otid(), w = __builtin_amdgcn_readfirstlane(tid >> 6), lane = tid & 63, r = lane & 31, h = lane >> 5;
    constexpr int ST = 144, KB = 64 * ST, BUF = 2 * KB;
    const bool active = 32 * w < nq;
    bf16x8 qf[4];
    {
        const int row = qrow0 + (active ? 32 * w + r : r);
#pragma unroll
        for (int s = 0; s < 4; ++s) qf[s] = *(const bf16x8*)(SQ + (size_t)row * 256 + head * 64 + 16 * s + 8 * h);
    }
    const int qp = qpos0 + 32 * w + r;
    const int wmax = active ? qpos0 + 32 * w + 30 : -1;
    const int Ttop = (qpos0 + nq - 2) >> 6;
    const int lk = tid >> 3, lc = tid & 7;
    u32x4 gk, gv;
#define SB_LOAD(T) do { const int tn_ = ck ? (T) - 16 : (T); const float* kp_ = (ck && (T) < 16) ? ck + (size_t)(64 * (T) + lk) * 256 : kf + (size_t)(64 * tn_ + lk) * 256; \
        const float* vp_ = (ck && (T) < 16) ? cvp + (size_t)(64 * (T) + lk) * 256 : vf + (size_t)(64 * tn_ + lk) * 256; const int o_ = head * 64 + lc * 8; \
        const f32x4 k0_ = *(const f32x4*)(kp_ + o_), k1_ = *(const f32x4*)(kp_ + o_ + 4), v0_ = *(const f32x4*)(vp_ + o_), v1_ = *(const f32x4*)(vp_ + o_ + 4); \
        gk.x = pk2(k0_[0], k0_[1]); gk.y = pk2(k0_[2], k0_[3]); gk.z = pk2(k1_[0], k1_[1]); gk.w = pk2(k1_[2], k1_[3]); gv.x = pk2(v0_[0], v0_[1]); gv.y = pk2(v0_[2], v0_[3]); gv.z = pk2(v1_[0], v1_[1]); gv.w = pk2(v1_[2], v1_[3]); } while (0)
#define SB_STORE(bi) do { LAS unsigned char* b_ = lds + (bi) * BUF; *(LAS u32x4*)(b_ + lk * ST + lc * 16) = gk; *(LAS u32x4*)(b_ + KB + lk * ST + lc * 16) = gv; } while (0)
    SB_LOAD(Ttop); SB_STORE(0);
    volatile LAS unsigned* fl = (volatile LAS unsigned*)(lds + LDS_MISC + 16);
    if (tid == 0) { fl[0] = 0u; fl[1] = 0u; fl[2] = 0u; }
    bool wdone = !active;
    __syncthreads();
    float A = 0.f;
    f32x16 o0, o1;
#pragma unroll
    for (int i = 0; i < 16; ++i) { o0[i] = 0.f; o1[i] = 0.f; }
    const int i16 = lane & 15, tq = i16 >> 2, tp = i16 & 3, blk = (lane >> 4) & 1;
    int it = 0;
    for (int T = Ttop; T >= 0; --T, ++it) {
        if (T > 0) SB_LOAD(T - 1);
        if (64 * T <= wmax && !wdone) {
            LAS const unsigned char* base = lds + (it & 1) * BUF;
            f32x16 z[2];
#pragma unroll
            for (int i = 0; i < 16; ++i) { z[0][i] = 0.f; z[1][i] = 0.f; }
#pragma unroll
            for (int s = 0; s < 4; ++s) {
                const bf16x8 a0 = *(LAS const bf16x8*)(base + r * ST + (16 * s + 8 * h) * 2);
                const bf16x8 a1 = *(LAS const bf16x8*)(base + (32 + r) * ST + (16 * s + 8 * h) * 2);
                z[0] = MFMA32(a0, qf[s], z[0]); z[1] = MFMA32(a1, qf[s], z[1]);
            }
            f32x16 L[2];
            float G[2][4], Go[2][4];
#pragma unroll
            for (int kt = 0; kt < 2; ++kt) {
#pragma unroll
                for (int i = 0; i < 16; ++i) {
                    const int key = 64 * T + 32 * kt + crow(i, h);
                    const float zz = z[kt][i];
                    const float e = ex2(-fabsf(zz) * LOG2E);
                    const float sp = fmaxf(zz, 0.f) + lg2(1.f + e) * LN2;
                    const bool valid = key < qp;
                    L[kt][i] = valid ? -sp : 0.f;
                    z[kt][i] = valid ? (zz - sp) : -1e30f;
                }
#pragma unroll
                for (int g = 0; g < 4; ++g) { G[kt][g] = (L[kt][4 * g] + L[kt][4 * g + 1]) + (L[kt][4 * g + 2] + L[kt][4 * g + 3]); Go[kt][g] = shx(G[kt][g], lane, 32); }
            }
            float run = A;
#pragma unroll
            for (int kt = 1; kt >= 0; --kt)
#pragma unroll
                for (int g = 3; g >= 0; --g) {
                    float af = run + (h == 0 ? Go[kt][g] : 0.f);
                    z[kt][4 * g + 3] = ex2((z[kt][4 * g + 3] + af) * LOG2E); af += L[kt][4 * g + 3];
                    z[kt][4 * g + 2] = ex2((z[kt][4 * g + 2] + af) * LOG2E); af += L[kt][4 * g + 2];
                    z[kt][4 * g + 1] = ex2((z[kt][4 * g + 1] + af) * LOG2E); af += L[kt][4 * g + 1];
                    z[kt][4 * g + 0] = ex2((z[kt][4 * g + 0] + af) * LOG2E);
                    run += (h == 0 ? G[kt][g] + Go[kt][g] : Go[kt][g] + G[kt][g]);
                }
            A = run;
            wdone = __builtin_amdgcn_ballot_w64(A < -150.f) == ~0ull;
            LAS const unsigned char* vb = base + KB;
#pragma unroll
            for (int kt = 0; kt < 2; ++kt)
#pragma unroll
                for (int ss = 0; ss < 2; ++ss) {
                    const bf16x8 pb = packfrag(z[kt], ss);
                    LAS const unsigned char* vp = vb + (32 * kt + 16 * ss + 4 * h + tq) * ST + (16 * blk + 4 * tp) * 2;
                    const bf16x8 a0 = tr_frag(vp, 8 * ST), a1 = tr_frag(vp + 64, 8 * ST);
                    o0 = MFMA32(a0, pb, o0); o1 = MFMA32(a1, pb, o1);
                }
        }
        if (T > 0) SB_STORE((it + 1) & 1);
        const int fw = it % 3;
        if (lane == 0 && !wdone) fl[fw] = 1u;
        LBAR();
        const unsigned alive = fl[fw];
        if (tid == 0) fl[(it + 2) % 3] = 0u;
        if (!alive) break;
    }
#undef SB_LOAD
#undef SB_STORE
    if (active) {
        bf16_t* orow_ = MIX + (size_t)(qrow0 + 32 * w + r) * 1024 + 768 + head * 64;
#pragma unroll
        for (int g = 0; g < 4; ++g) {
            float a[4], b[4];
#pragma unroll
            for (int j = 0; j < 4; ++j) { a[j] = o0[4 * g + j]; b[j] = o1[4 * g + j]; }
            *(u32x2*)(orow_ + 8 * g + 4 * h) = pack4(a);
            *(u32x2*)(orow_ + 32 + 8 * g + 4 * h) = pack4(b);
        }
    }
}

DI void uc_item(int g_wave, LAS unsigned char* lds, const bf16_t* RK, const bf16_t* RV, float* dst, int row0, int head) {
    const int tid = otid(), w = __builtin_amdgcn_readfirstlane(tid >> 6), lane = tid & 63, h = lane >> 5;
    constexpr int ST = 144, TB = 64 * ST;
    const float lgam = lg2(1.f - ex2(-5.f - (float)head));
    const int lk = tid >> 3, lc = tid & 7;
    const float kdec = ex2(lgam * (float)(63 - lk));
    {
        const size_t rr_ = (size_t)(row0 + lk) * 256 + head * 64 + lc * 8;
        const u32x4 gk = *(const u32x4*)(RK + rr_), gv = *(const u32x4*)(RV + rr_);
        u32x4 kd_; kd_.x = pk2(bflo(gk.x) * kdec, bfhi(gk.x) * kdec); kd_.y = pk2(bflo(gk.y) * kdec, bfhi(gk.y) * kdec); kd_.z = pk2(bflo(gk.z) * kdec, bfhi(gk.z) * kdec); kd_.w = pk2(bflo(gk.w) * kdec, bfhi(gk.w) * kdec);
        *(LAS u32x4*)(lds + lk * ST + lc * 16) = kd_; *(LAS u32x4*)(lds + TB + lk * ST + lc * 16) = gv;
    }
    __syncthreads();
    if (w < 4) {
        const int et = w >> 1, dt = w & 1;
        const int i16 = lane & 15, tq = i16 >> 2, tp = i16 & 3, blk = (lane >> 4) & 1;
        f32x16 sacc;
#pragma unroll
        for (int i = 0; i < 16; ++i) sacc[i] = 0.f;
#pragma unroll
        for (int ks = 0; ks < 4; ++ks) {
            LAS const unsigned char* vp = lds + TB + (16 * ks + 4 * h + tq) * ST + (32 * et + 16 * blk + 4 * tp) * 2;
            LAS const unsigned char* kp = lds + (16 * ks + 4 * h + tq) * ST + (32 * dt + 16 * blk + 4 * tp) * 2;
            const bf16x8 a = tr_frag(vp, 8 * ST), b = tr_frag(kp, 8 * ST);
            sacc = MFMA32(a, b, sacc);
        }
#pragma unroll
        for (int g = 0; g < 4; ++g) *(f32x4*)(dst + ((w * 4 + g) * 64 + lane) * 4) = (f32x4){sacc[4 * g], sacc[4 * g + 1], sacc[4 * g + 2], sacc[4 * g + 3]};
    }
    __syncthreads();
}

DI void ret_item(int g_wave, LAS unsigned char* lds, const bf16_t* RQ, const bf16_t* RK, const bf16_t* RV, const bf16_t* RG, const float* gret, bf16_t* MIX,
                 int row0, int nchunks, int head, const float* S0, float* Sout, const float* UCb, int c0) {
    const int tid = otid(), w = __builtin_amdgcn_readfirstlane(tid >> 6), lane = tid & 63, r = lane & 31, h = lane >> 5;
    constexpr int ST = 144, TB = 64 * ST, DBUF = 5 * TB, SOFF = 2 * DBUF;
    const float lgam = lg2(1.f - ex2(-5.f - (float)head));
    const float g64 = ex2(lgam * 64.f);
    const int lk = tid >> 3, lc = tid & 7;
    const float kdec = ex2(lgam * (float)(63 - lk));
    u32x4 aq, ak, av, ag, bq, bk, bv, bg;
#define RT_LOADX(c, gq, gk, gv, gg) do { const size_t rr_ = (size_t)(row0 + 64 * (c) + lk) * 256 + head * 64 + lc * 8; gq = *(const u32x4*)(RQ + rr_); gk = *(const u32x4*)(RK + rr_); gv = *(const u32x4*)(RV + rr_); gg = *(const u32x4*)(RG + rr_); } while (0)
#define RT_STOREX(bi, gq, gk, gv, gg) do { LAS unsigned char* b_ = lds + (bi) * DBUF + lk * ST + lc * 16; *(LAS u32x4*)(b_) = gq; *(LAS u32x4*)(b_ + TB) = gk; \
        u32x4 kd_; kd_.x = pk2(bflo(gk.x) * kdec, bfhi(gk.x) * kdec); kd_.y = pk2(bflo(gk.y) * kdec, bfhi(gk.y) * kdec); kd_.z = pk2(bflo(gk.z) * kdec, bfhi(gk.z) * kdec); kd_.w = pk2(bflo(gk.w) * kdec, bfhi(gk.w) * kdec); \
        *(LAS u32x4*)(b_ + 2 * TB) = kd_; *(LAS u32x4*)(b_ + 3 * TB) = gv; *(LAS u32x4*)(b_ + 4 * TB) = gg; } while (0)
    RT_LOADX(0, aq, ak, av, ag); RT_STOREX(0, aq, ak, av, ag);
    if (nchunks > 1) RT_LOADX(1, aq, ak, av, ag);
    if (tid < 16) *(LAS f32x4*)(lds + SOFF + 2 * TB + tid * 16) = *(const f32x4*)(gret + head * 64 + tid * 4);
    const int et = (w - 2) >> 1, dt = (w - 2) & 1;
    f32x16 sacc;
#pragma unroll
    for (int i = 0; i < 16; ++i) sacc[i] = 0.f;
    if (w >= 2 && w < 6) {
        LAS unsigned char* st1 = lds + SOFF + TB;
#pragma unroll
        for (int g = 0; g < 4; ++g) {
            f32x4 v = (f32x4){0.f, 0.f, 0.f, 0.f};
            if (S0) v = *(const f32x4*)(S0 + (size_t)(32 * dt + r) * 64 + 32 * et + 8 * g + 4 * h);
            if (UCb) {
                for (int j = 0; j < c0; ++j) { const f32x4 u = *(const f32x4*)(UCb + (size_t)j * 4096 + (((w - 2) * 4 + g) * 64 + lane) * 4); v = v * g64 + u; }
            }
#pragma unroll
            for (int j = 0; j < 4; ++j) { sacc[4 * g + j] = v[j]; *(LAS bf16_t*)(st1 + (32 * et + 8 * g + 4 * h + j) * ST + (32 * dt + r) * 2) = (bf16_t)(pk2(v[j], 0.f) & 0xffffu); }
        }
    }
    const int lq = 32 * (w & 1) + r;
    const float gl = ex2(lgam * (float)lq), qd = ex2(lgam * (float)(lq + 1));
    float gm[2][16];
#pragma unroll
    for (int mt = 0; mt < 2; ++mt)
#pragma unroll
        for (int i = 0; i < 16; ++i) { const int mm = 32 * mt + crow(i, h); gm[mt][i] = (lq >= mm) ? gl * ex2(-lgam * (float)mm) : 0.f; }
    __syncthreads();
    const int i16 = lane & 15, tq = i16 >> 2, tp = i16 & 3, blk = (lane >> 4) & 1;
    for (int c0 = 0; c0 < nchunks; c0 += 2) {
        {
        const int c = c0;
        if (c + 2 < nchunks) RT_LOADX(c + 2, bq, bk, bv, bg);
        LAS const unsigned char* base = lds + (c & 1) * DBUF;
        LAS const unsigned char* stp = lds + SOFF + ((c + 1) & 1) * TB;
        LAS unsigned char* stn = lds + SOFF + (c & 1) * TB;
        if (w < 2 || w >= 6) {
            const int oe = w >= 6 ? 1 : 0;
            bf16x8 qf[4];
#pragma unroll
            for (int s = 0; s < 4; ++s) qf[s] = *(LAS const bf16x8*)(base + lq * ST + (16 * s + 8 * h) * 2);
            f32x16 at[2];
#pragma unroll
            for (int i = 0; i < 16; ++i) { at[0][i] = 0.f; at[1][i] = 0.f; }
#pragma unroll
            for (int s = 0; s < 4; ++s) {
                const bf16x8 a0 = *(LAS const bf16x8*)(base + TB + r * ST + (16 * s + 8 * h) * 2);
                const bf16x8 a1 = *(LAS const bf16x8*)(base + TB + (32 + r) * ST + (16 * s + 8 * h) * 2);
                at[0] = MFMA32(a0, qf[s], at[0]); at[1] = MFMA32(a1, qf[s], at[1]);
            }
#pragma unroll
            for (int mt = 0; mt < 2; ++mt)
#pragma unroll
                for (int i = 0; i < 16; ++i) at[mt][i] *= gm[mt][i];
            f32x16 pv, sq_;
#pragma unroll
            for (int i = 0; i < 16; ++i) { pv[i] = 0.f; sq_[i] = 0.f; }
#pragma unroll
            for (int mt = 0; mt < 2; ++mt)
#pragma unroll
                for (int ss = 0; ss < 2; ++ss) {
                    const bf16x8 pb = packfrag(at[mt], ss);
                    LAS const unsigned char* vp = base + 3 * TB + (32 * mt + 16 * ss + 4 * h + tq) * ST + (32 * oe + 16 * blk + 4 * tp) * 2;
                    pv = MFMA32(tr_frag(vp, 8 * ST), pb, pv);
                }
#pragma unroll
            for (int s = 0; s < 4; ++s) {
                const bf16x8 a0 = *(LAS const bf16x8*)(stp + (32 * oe + r) * ST + (16 * s + 8 * h) * 2);
                sq_ = MFMA32(a0, qf[s], sq_);
            }
            float s1 = 0.f, s2 = 0.f;
#pragma unroll
            for (int i = 0; i < 16; ++i) { pv[i] += qd * sq_[i]; s1 += pv[i]; s2 += pv[i] * pv[i]; }
            s1 += shx(s1, lane, 32); s2 += shx(s2, lane, 32);
            LAS f32x2* xs = (LAS f32x2*)(lds + SOFF + 2 * TB + 256);
            if (h == 0) xs[oe * 64 + lq] = (f32x2){s1, s2};
            LBAR();
            const f32x2 po = xs[(oe ^ 1) * 64 + lq];
            const float t1 = oe ? po[0] + s1 : s1 + po[0], t2 = oe ? po[1] + s2 : s2 + po[1];
            const float mu = t1 * (1.f / 64.f);
            const float rs = rsqrtf(fmaxf(t2 * (1.f / 64.f) - mu * mu, 0.f) + EPS);
            const size_t row = (size_t)(row0 + 64 * c + lq);
#pragma unroll
            for (int g = 0; g < 4; ++g) {
                const int el = 32 * oe + 8 * g + 4 * h, ec = head * 64 + el;
                const u32x2 gg = *(LAS const u32x2*)(base + 4 * TB + lq * ST + el * 2);
                const f32x4 gr = *(LAS const f32x4*)(lds + SOFF + 2 * TB + el * 4);
                float o[4];
                o[0] = (pv[4 * g + 0] - mu) * rs * gr[0] * bflo(gg.x); o[1] = (pv[4 * g + 1] - mu) * rs * gr[1] * bfhi(gg.x);
                o[2] = (pv[4 * g + 2] - mu) * rs * gr[2] * bflo(gg.y); o[3] = (pv[4 * g + 3] - mu) * rs * gr[3] * bfhi(gg.y);
                *(u32x2*)(MIX + row * 1024 + 512 + ec) = pack4(o);
            }
        } else if (w < 6) {
#pragma unroll
            for (int i = 0; i < 16; ++i) sacc[i] *= g64;
#pragma unroll
            for (int ks = 0; ks < 4; ++ks) {
                LAS const unsigned char* vp = base + 3 * TB + (16 * ks + 4 * h + tq) * ST + (32 * et + 16 * blk + 4 * tp) * 2;
                LAS const unsigned char* kp = base + 2 * TB + (16 * ks + 4 * h + tq) * ST + (32 * dt + 16 * blk + 4 * tp) * 2;
                const bf16x8 a = tr_frag(vp, 8 * ST), b = tr_frag(kp, 8 * ST);
                sacc = MFMA32(a, b, sacc);
            }
#pragma unroll
            for (int i = 0; i < 16; ++i) *(LAS bf16_t*)(stn + (32 * et + crow(i, h)) * ST + (32 * dt + r) * 2) = (bf16_t)(pk2(sacc[i], 0.f) & 0xffffu);
            LBAR();
        }
        if (c + 1 < nchunks) RT_STOREX((c + 1) & 1, aq, ak, av, ag);
        LBAR();
            }
        if (c0 + 1 >= nchunks) break;
        {
        const int c = c0 + 1;
        if (c + 2 < nchunks) RT_LOADX(c + 2, aq, ak, av, ag);
        LAS const unsigned char* base = lds + (c & 1) * DBUF;
        LAS const unsigned char* stp = lds + SOFF + ((c + 1) & 1) * TB;
        LAS unsigned char* stn = lds + SOFF + (c & 1) * TB;
        if (w < 2 || w >= 6) {
            const int oe = w >= 6 ? 1 : 0;
            bf16x8 qf[4];
#pragma unroll
            for (int s = 0; s < 4; ++s) qf[s] = *(LAS const bf16x8*)(base + lq * ST + (16 * s + 8 * h) * 2);
            f32x16 at[2];
#pragma unroll
            for (int i = 0; i < 16; ++i) { at[0][i] = 0.f; at[1][i] = 0.f; }
#pragma unroll
            for (int s = 0; s < 4; ++s) {
                const bf16x8 a0 = *(LAS const bf16x8*)(base + TB + r * ST + (16 * s + 8 * h) * 2);
                const bf16x8 a1 = *(LAS const bf16x8*)(base + TB + (32 + r) * ST + (16 * s + 8 * h) * 2);
                at[0] = MFMA32(a0, qf[s], at[0]); at[1] = MFMA32(a1, qf[s], at[1]);
            }
#pragma unroll
            for (int mt = 0; mt < 2; ++mt)
#pragma unroll
                for (int i = 0; i < 16; ++i) at[mt][i] *= gm[mt][i];
            f32x16 pv, sq_;
#pragma unroll
            for (int i = 0; i < 16; ++i) { pv[i] = 0.f; sq_[i] = 0.f; }
#pragma unroll
            for (int mt = 0; mt < 2; ++mt)
#pragma unroll
                for (int ss = 0; ss < 2; ++ss) {
                    const bf16x8 pb = packfrag(at[mt], ss);
                    LAS const unsigned char* vp = base + 3 * TB + (32 * mt + 16 * ss + 4 * h + tq) * ST + (32 * oe + 16 * blk + 4 * tp) * 2;
                    pv = MFMA32(tr_frag(vp, 8 * ST), pb, pv);
                }
#pragma unroll
            for (int s = 0; s < 4; ++s) {
                const bf16x8 a0 = *(LAS const bf16x8*)(stp + (32 * oe + r) * ST + (16 * s + 8 * h) * 2);
                sq_ = MFMA32(a0, qf[s], sq_);
            }
            float s1 = 0.f, s2 = 0.f;
#pragma unroll
            for (int i = 0; i < 16; ++i) { pv[i] += qd * sq_[i]; s1 += pv[i]; s2 += pv[i] * pv[i]; }
            s1 += shx(s1, lane, 32); s2 += shx(s2, lane, 32);
            LAS f32x2* xs = (LAS f32x2*)(lds + SOFF + 2 * TB + 256);
            if (h == 0) xs[oe * 64 + lq] = (f32x2){s1, s2};
            LBAR();
            const f32x2 po = xs[(oe ^ 1) * 64 + lq];
            const float t1 = oe ? po[0] + s1 : s1 + po[0], t2 = oe ? po[1] + s2 : s2 + po[1];
            const float mu = t1 * (1.f / 64.f);
            const float rs = rsqrtf(fmaxf(t2 * (1.f / 64.f) - mu * mu, 0.f) + EPS);
            const size_t row = (size_t)(row0 + 64 * c + lq);
#pragma unroll
            for (int g = 0; g < 4; ++g) {
                const int el = 32 * oe + 8 * g + 4 * h, ec = head * 64 + el;
                const u32x2 gg = *(LAS const u32x2*)(base + 4 * TB + lq * ST + el * 2);
                const f32x4 gr = *(LAS const f32x4*)(lds + SOFF + 2 * TB + el * 4);
                float o[4];
                o[0] = (pv[4 * g + 0] - mu) * rs * gr[0] * bflo(gg.x); o[1] = (pv[4 * g + 1] - mu) * rs * gr[1] * bfhi(gg.x);
                o[2] = (pv[4 * g + 2] - mu) * rs * gr[2] * bflo(gg.y); o[3] = (pv[4 * g + 3] - mu) * rs * gr[3] * bfhi(gg.y);
                *(u32x2*)(MIX + row * 1024 + 512 + ec) = pack4(o);
            }
        } else if (w < 6) {
#pragma unroll
            for (int i = 0; i < 16; ++i) sacc[i] *= g64;
#pragma unroll
            for (int ks = 0; ks < 4; ++ks) {
                LAS const unsigned char* vp = base + 3 * TB + (16 * ks + 4 * h + tq) * ST + (32 * et + 16 * blk + 4 * tp) * 2;
                LAS const unsigned char* kp = base + 2 * TB + (16 * ks + 4 * h + tq) * ST + (32 * dt + 16 * blk + 4 * tp) * 2;
                const bf16x8 a = tr_frag(vp, 8 * ST), b = tr_frag(kp, 8 * ST);
                sacc = MFMA32(a, b, sacc);
            }
#pragma unroll
            for (int i = 0; i < 16; ++i) *(LAS bf16_t*)(stn + (32 * et + crow(i, h)) * ST + (32 * dt + r) * 2) = (bf16_t)(pk2(sacc[i], 0.f) & 0xffffu);
            LBAR();
        }
        if (c + 1 < nchunks) RT_STOREX((c + 1) & 1, bq, bk, bv, bg);
        LBAR();
            }
    }
#undef RT_LOADX
#undef RT_STOREX
    if (Sout && w >= 2 && w < 6) {
#pragma unroll
        for (int g = 0; g < 4; ++g)
            *(f32x4*)(Sout + (size_t)(32 * dt + r) * 64 + 32 * et + 8 * g + 4 * h) = (f32x4){sacc[4 * g], sacc[4 * g + 1], sacc[4 * g + 2], sacc[4 * g + 3]};
    }
}


#define XB_TMO      128
#define XB_XCNT(j)  (256  + 64 * (j))
#define XB_XSUB(j)  (1280 + 64 * (j))
#define XB_XGEN(j)  (2304 + 64 * (j))
#define XB_TOP      3328
#define XB_TOPGEN   3392
#define XCD_BAR_WORDS 3456
#define XB_SPIN_CAP (1u << 20)
DI unsigned xb_ld(unsigned* p)              { return __hip_atomic_load(p, __ATOMIC_RELAXED, __HIP_MEMORY_SCOPE_AGENT); }
DI unsigned xb_add(unsigned* p, unsigned v) { return __hip_atomic_fetch_add(p, v, __ATOMIC_RELAXED, __HIP_MEMORY_SCOPE_AGENT); }
DI unsigned xb_xcc_id() { return (unsigned)__builtin_amdgcn_s_getreg((3 << 11) | 20) & 0xFu; }
#define XB_SPIN(cond, bar) do { unsigned _sp = 0; while (cond) { __builtin_amdgcn_s_sleep(1); \
    if ((++_sp & 255u) == 0u) { if (xb_ld(&(bar)[XB_TMO])) break; if (_sp > XB_SPIN_CAP) { atomicAdd(&(bar)[XB_TMO], 1u); break; } } } } while (0)
DI void xcd_barrier_complete(unsigned* bar, unsigned x, unsigned& nloc, unsigned& nx) {
    const unsigned G = gridDim.x * gridDim.y * gridDim.z;
    unsigned sum, cnt, mine, sp = 0u;
    for (;;) {
        sum = 0u; cnt = 0u; mine = 0u;
#pragma unroll
        for (unsigned j = 0; j < 16; ++j) { const unsigned c = xb_ld(&bar[XB_XCNT(j)]); sum += c; cnt += (c > 0u) ? 1u : 0u; mine = (j == x) ? c : mine; }
        if (sum == G) break;
        __builtin_amdgcn_s_sleep(1);
        if ((++sp & 255u) == 0u) { if (xb_ld(&bar[XB_TMO])) break; if (sp > XB_SPIN_CAP) { atomicAdd(&bar[XB_TMO], 1u); break; } }
    }
    nloc = mine > 0u ? mine : 1u; nx = cnt > 0u ? cnt : 1u;
}
DI void xcd_barrier(unsigned* bar, volatile LAS unsigned* st, bool leader) {
    asm volatile("s_waitcnt vmcnt(0)" ::: "memory");
    __syncthreads();
    if (leader) {
        const unsigned x = xb_xcc_id();
        __builtin_amdgcn_s_waitcnt(0);
        unsigned nloc = st[0], nx = st[1];
        if (nloc == 0u) { xcd_barrier_complete(bar, x, nloc, nx); st[0] = nloc; st[1] = nx; }
        const unsigned old = xb_add(&bar[XB_XSUB(x)], 1u);
        const unsigned gen = old / nloc;
        if (old + 1u == (gen + 1u) * nloc) {
            __builtin_amdgcn_fence(__ATOMIC_RELEASE, "agent");
            asm volatile("s_waitcnt vmcnt(0)" ::: "memory");
            const unsigned og = xb_add(&bar[XB_TOP], 1u);
            const unsigned tg = og / nx;
            if (og + 1u == (tg + 1u) * nx) xb_add(&bar[XB_TOPGEN], 1u);
            else XB_SPIN(xb_ld(&bar[XB_TOPGEN]) == tg, bar);
            __builtin_amdgcn_fence(__ATOMIC_ACQUIRE, "agent");
            xb_add(&bar[XB_XGEN(x)], 1u);
            asm volatile("s_waitcnt vmcnt(0)" ::: "memory");
        } else {
            XB_SPIN(xb_ld(&bar[XB_XGEN(x)]) == gen, bar);
            __builtin_amdgcn_fence(__ATOMIC_ACQUIRE, "agent");
            asm volatile("s_waitcnt vmcnt(0)" ::: "memory");
        }
    }
    __syncthreads();
}

DI int colmap(int job, int n) {
    switch (job) {
        case 0: {
            const int T = n >> 8, c = n & 255;
            if (T == 0) return 384 + c;
            if (T == 1) return c;
            if (T == 2) { if (c < 128) return 256 + c; if (c < 160) { const int p = c - 128; return 640 + 4 * (p >> 3) + (p & 3) + 16 * ((p >> 2) & 1); } return -1; }
            if (T == 3 || T == 4) { const int hh = c >> 6, p = c & 63; return (T == 3 ? 672 : 928) + 64 * hh + 4 * (p >> 3) + (p & 3) + 32 * ((p >> 2) & 1); }
            return 1184 + (T - 5) * 256 + c;
        }
        case 1: {
            if (n < 512) return (n >> 6) * 96 + (n & 63);
            const int q = n - 512, hh = q >> 5, p = q & 31; return hh * 96 + 64 + 4 * (p >> 3) + (p & 3) + 16 * ((p >> 2) & 1);
        }
        case 2: case 3: return n < 512 ? (n >> 6) * 128 + (n & 63) : ((n - 512) >> 6) * 128 + 64 + (n & 63);
        case 5: { const int j = n >> 8, c = n & 255; return c < 128 ? 128 * j + c : DFF + 128 * j + (c - 128); }
        default: return n;
    }
}
DI void transpose_item(int g_wave, LAS unsigned char* lds, const float* src, int K, int Nsrc, bf16_t* dst, int job, const float* rscale, int kt, int ntile) {
    LAS float* t = (LAS float*)lds;
    const int tid = otid();
    {
        const int nl = tid & 255, k0 = tid >> 8;
        const int ns = colmap(job, ntile * 256 + nl);
        float v[32];
#pragma unroll
        for (int kk = 0; kk < 32; ++kk) { const int k = kt * 64 + k0 + 2 * kk; v[kk] = ns >= 0 ? src[(size_t)k * Nsrc + ns] : 0.f; }
        if (rscale) {
#pragma unroll
            for (int kk = 0; kk < 32; ++kk) v[kk] *= rscale[kt * 64 + k0 + 2 * kk];
        }
#pragma unroll
        for (int kk = 0; kk < 32; ++kk) t[(k0 + 2 * kk) * 257 + nl] = v[kk];
    }
    __syncthreads();
#pragma unroll
    for (int q = 0; q < 4; ++q) {
        const int idx = tid + 512 * q, nl = idx >> 3, ks = idx & 7;
        float v[8];
#pragma unroll
        for (int j = 0; j < 8; ++j) v[j] = t[(ks * 8 + j) * 257 + nl];
        *(u32x4*)(dst + (size_t)(ntile * 256 + nl) * K + kt * 64 + ks * 8) = pack8(v);
    }
    __syncthreads();
}

#ifndef REP_SYNC
#define REP_SYNC 1
#endif
#define GSYNC() do { for (int r_ = 0; r_ < REP_SYNC; ++r_) { const int t_ = otid(); xcd_barrier((unsigned*)(osp(P.ws) + WS_CTL), (volatile LAS unsigned*)(lds + LDS_MISC + 8), t_ == 0); } } while (0)
#define PIN(i) gptr(P.in[i])
#define PH_BEGIN const int tid = otid(); const int G = gridDim.x; const int bid = osi((int)blockIdx.x); unsigned char* ws = osp(P.ws); float* out = osp(P.out); unsigned char* U = ws + WS_U; (void)tid; (void)G; (void)bid; (void)out; (void)U;
#define WSP(T, off) ((T*)(ws + (off)))
#define UP(off) ((bf16_t*)(U + (off)))

#define TRANSPOSE_DISPATCH(l_, q_) do { const int l = (l_), q = (q_); \
            int j, qi, K, Ns; size_t off; const float* srcb; \
            if (q < 160) { j = 0; qi = q; K = 1024; Ns = 2464; srcb = PIN(I_WIN); off = W_IN; } \
            else if (q < 178) { j = 1; qi = q - 160; K = 384; Ns = 768; srcb = PIN(I_WUQ); off = W_UQ; } \
            else if (q < 194) { j = 2; qi = q - 178; K = 256; Ns = 1024; srcb = PIN(I_WUKV); off = W_UKVG; } \
            else if (q < 210) { j = 3; qi = q - 194; K = 256; Ns = 1024; srcb = PIN(I_WUKV); off = W_UKV; } \
            else if (q < 274) { j = 4; qi = q - 210; K = 1024; Ns = 1024; srcb = PIN(I_WO); off = W_O; } \
            else if (q < 626) { j = 5; qi = q - 274; K = 1024; Ns = NUP; srcb = PIN(I_WUP); off = W_UP; } \
            else { j = 6; qi = q - 626; K = DFF; Ns = 1024; srcb = PIN(I_WDN); off = W_DN; } \
            const int nkt = K / 64, kt = qi % nkt, ntile = qi / nkt; \
            const float* src = srcb + (size_t)l * K * Ns; \
            const float* rs = j == 1 ? PIN(I_GQ) + l * 384 : (j == 2 ? PIN(I_GKV) + l * 256 : nullptr); \
            transpose_item(g_wave, lds, src, K, Ns, (bf16_t*)(ws + WS_W + l * W_LAYER + off), j, rs, kt, ntile); } while (0)

__global__ void __launch_bounds__(512, 2) mega(Params P) {
    extern __shared__ __attribute__((aligned(16))) unsigned char lds_raw[];
    LAS unsigned char* lds = (LAS unsigned char*)lds_raw;
    cg::grid_group grid = cg::this_grid();
    const int g_wave = __builtin_amdgcn_readfirstlane((int)threadIdx.x >> 6);
    if (threadIdx.x == 0) { *(volatile LAS unsigned*)(lds + LDS_MISC + 8) = 0u; *(volatile LAS unsigned*)(lds + LDS_MISC + 12) = 0u; (void)xb_add((unsigned*)(gptr(P.ws) + WS_CTL) + XB_XCNT(xb_xcc_id()), 1u); }
    __syncthreads();
    grid.sync();

#ifndef REP_P0
#define REP_P0 1
#endif
    for (int rep0 = 0; rep0 < REP_P0; ++rep0) {
        PH_BEGIN
        float* MOD = WSP(float, WS_MOD);
        for (int it = bid; it < 192; it += G) {
            const int l = it / 96, cb = it % 96;
            LAS float* sc = (LAS float*)lds;
            for (int idx = tid; idx < 24 * 1024; idx += 512) { const int b = idx >> 10, k = idx & 1023; const float c = b < 8 ? PIN(I_CP)[b * 1024 + k] : PIN(I_CS)[(b - 8) * 1024 + k]; sc[idx] = silu(c); }
            __syncthreads();
            const int cl0 = tid & 63, ks = tid >> 6;
            float acc[24];
#pragma unroll
            for (int b = 0; b < 24; ++b) acc[b] = 0.f;
            const float* wp = PIN(I_WADA) + (size_t)l * 1024 * 6144 + cb * 64 + cl0;
#pragma unroll 4
            for (int k4 = ks * 128; k4 < ks * 128 + 128; k4 += 4) {
                const float w0 = wp[(size_t)k4 * 6144], w1 = wp[(size_t)(k4 + 1) * 6144], w2 = wp[(size_t)(k4 + 2) * 6144], w3 = wp[(size_t)(k4 + 3) * 6144];
#pragma unroll
                for (int b = 0; b < 24; ++b) { const f32x4 sv = *(LAS const f32x4*)(sc + b * 1024 + k4); acc[b] += (sv[0] * w0 + sv[1] * w1) + (sv[2] * w2 + sv[3] * w3); }
            }
            __syncthreads();
#pragma unroll
            for (int b = 0; b < 24; ++b) sc[(ks * 24 + b) * 64 + cl0] = acc[b];
            __syncthreads();
            for (int idx = tid; idx < 24 * 64; idx += 512) {
                const int b = idx >> 6, cl = idx & 63;
                float sm = 0.f;
#pragma unroll
                for (int q = 0; q < 8; ++q) sm += sc[(q * 24 + b) * 64 + cl];
                const float mv = sm + PIN(I_BADA)[(size_t)l * 6144 + cb * 64 + cl];
                MOD[((size_t)l * 24 + b) * 6144 + cb * 64 + cl] = mv;
                const int col = cb * 64 + cl;
                if (col < 1024) WSP(bf16_t, WS_SHM)[(size_t)(32 * (2 * l) + b) * 1024 + col] = (bf16_t)(pk2(mv, 0.f) & 0xffffu);
                else if (col >= 3072 && col < 4096) WSP(bf16_t, WS_SHM)[(size_t)(32 * (2 * l + 1) + b) * 1024 + (col - 3072)] = (bf16_t)(pk2(mv, 0.f) & 0xffffu);
            }
            __syncthreads();
        }
        constexpr int per_layer = 160 + 18 + 16 + 16 + 64 + 352 + 176;
        for (int it = (bid + G - 192 % G) % G; it < per_layer; it += G) TRANSPOSE_DISPATCH(0, it);
        {
            bf16_t* CLB = WSP(bf16_t, WS_CLB);
            const size_t n8 = (size_t)2 * 16384 * 256 / 8;
            const float* src = PIN(I_CLAT);
#pragma unroll 4
            for (size_t i = (size_t)bid * 512 + tid; i < n8; i += (size_t)G * 512) {
                const f32x4 a = *(const f32x4*)(src + i * 8), b = *(const f32x4*)(src + i * 8 + 4);
                u32x4 w; w.x = pk2(a[0], a[1]); w.y = pk2(a[2], a[3]); w.z = pk2(b[0], b[1]); w.w = pk2(b[2], b[3]);
                *(u32x4*)(CLB + i * 8) = w;
            }
        }
    }
    GSYNC();
    for (int q = 0; q < 2; ++q) {
        PH_BEGIN
        const int l = q >> 1, up = q & 1;
        EpiC e; e.dst = up ? WSP(float, WS_CV2) + (size_t)l * 24 * NUP : WSP(float, WS_CV1) + (size_t)l * 24 * NIN; e.r0 = 32 * q; e.ldc = up ? NUP : NIN;
        run_gemm_w(g_wave, lds, WSP(bf16_t, WS_SHM), (const bf16_t*)(ws + WS_W + l * W_LAYER + (up ? W_UP : W_IN)), 256, up ? NUP : NIN, 1024, G - (q * 10) % G, e);
    }
    {
        PH_BEGIN
        float* MOD = WSP(float, WS_MOD); float* SSQ = WSP(float, WS_SSQ); bf16_t* AP = UP(U_AP);
        if (bid >= 32) {
        const int w = tid >> 6, lane = tid & 63;
        for (int row = (bid - 32) * 8 + w; row < MT; row += (G - 32) * 8) {
            int mb, pos, kvrow; row_info(row, mb, pos, kvrow);
            const float* xr = row < MP ? PIN(I_XP) + (size_t)row * 1024 : PIN(I_XS) + (size_t)(row - MP) * 1024;
            const float* sc1 = MOD + (size_t)mb * 6144 + 1024;
            float s = 0.f;
#pragma unroll
            for (int half = 0; half < 2; ++half) {
                const int c = half * 512 + lane * 8;
                float v[8];
#pragma unroll
                for (int q = 0; q < 2; ++q) {
                    const f32x4 x = *(const f32x4*)(xr + c + 4 * q), g = *(const f32x4*)(PIN(I_GN1) + c + 4 * q), sc = *(const f32x4*)(sc1 + c + 4 * q);
#pragma unroll
                    for (int j = 0; j < 4; ++j) { s += x[j] * x[j]; v[4 * q + j] = x[j] * g[j] * (1.f + sc[j]); }
                }
                *(u32x4*)(AP + (size_t)row * 1024 + c) = pack8(v);
            }
#pragma unroll
            for (int o = 32; o >= 1; o >>= 1) s += shx(s, lane, o);
            if (lane < 16) SSQ[(size_t)row * 16 + lane] = lane == 0 ? s : 0.f;
        }
        }
    }
    GSYNC();
    for (int l = 0; l < 2; ++l) {
#ifndef REP_P3
#define REP_P3 1
#endif
        if (l == 0) {
        for (int rep = 0; rep < REP_P3; ++rep) {
            PH_BEGIN
            EpiIn e; e.l = l; e.ws = ws; e.out = out; e.gkv = PIN(I_GKV) + l * 256; e.xl = lds + 131072;
            run_gemm_w(g_wave, lds, UP(U_AP), (const bf16_t*)(ws + WS_W + l * W_LAYER + W_IN), MT, NIN, 1024, 0, e);
            if (rep == 0 && bid >= 168) { constexpr int per_layer = 160 + 18 + 16 + 16 + 64 + 352 + 176; for (int it = bid - 168; it < per_layer; it += G - 168) TRANSPOSE_DISPATCH(1, it); }
        }
        GSYNC();
        }
#ifndef REP_P4G
#define REP_P4G 1
#endif
        for (int rep = 0; rep < REP_P4G; ++rep) {
            PH_BEGIN
            EpiQ eq; eq.ws = ws;
            run_gemm_w(g_wave, lds, UP(U_ZQ), (const bf16_t*)(ws + WS_W + l * W_LAYER + W_UQ), MT, 768, 384, 0, eq);
        }
        for (int mode = 0; mode < 2 * REP_P4G; ++mode) {
            PH_BEGIN
            EpiKV ek; ek.mode = mode & 1; ek.ws = ws;
            run_gemm_w(g_wave, lds, (mode & 1) ? WSP(bf16_t, WS_CLB) + (size_t)l * 16384 * 256 : UP(U_ZKV), (const bf16_t*)(ws + WS_W + l * W_LAYER + ((mode & 1) ? W_UKV : W_UKVG)), (mode & 1) ? 16384 : MT, 1024, 256,
                     G - ((mode & 1) ? 476 : 204) % G, ek);
        }
        {
            PH_BEGIN
#if RET_PAR
            for (int it = bid; it < 1024; it += G)
                uc_item(g_wave, lds, UP(U_RK), UP(U_RV), (float*)(U + U_UC) + (size_t)it * 4096, (it >> 7) * 2048 + 64 * (it & 31), (it >> 5) & 3);
#endif
            bf16_t* KR = UP(U_KR);
            for (int idx = bid * 512 + tid; idx < 16384 * 4; idx += G * 512) {
                const int srow = idx >> 2, c = (idx & 3) * 8;
                const float* s = PIN(I_CKR) + ((size_t)l * 16384 + srow) * 32 + c;
                const f32x4 a = *(const f32x4*)s, b = *(const f32x4*)(s + 4);
                u32x4 wv; wv.x = pk2(a[0], a[1]); wv.y = pk2(a[2], a[3]); wv.z = pk2(b[0], b[1]); wv.w = pk2(b[2], b[3]);
                *(u32x4*)(KR + (size_t)(MP + (srow >> 10) * KVS + (srow & 1023)) * 32 + c) = wv;
            }
        }
        GSYNC();
        {
            LAS int* sitem = (LAS int*)(lds + LDS_MISC);
#ifndef REP_P5
#define REP_P5 1
#endif
            for (int rep = 0; rep < REP_P5; ++rep)
            for (;;) {
                PH_BEGIN
                __syncthreads();
                if (tid == 0) *sitem = (int)atomicAdd(WSP(unsigned, WS_CTL) + 3600 + l + 2 * rep, 1u);
                __syncthreads();
                const int it = *sitem;
                if (it >= 1280) break;
                int type, b, hh, qb = 0, samp = 0, grp = 0;
#if RET_PAR
                if (it < 256) { type = 0; grp = 7 - (it >> 5); b = (it >> 2) & 7; hh = it & 3; }
#else
                if (it < 256) { if (it >= 32) continue; type = 0; grp = 7; b = (it >> 2) & 7; hh = it & 3; }
#endif
                else if (it < 384) { type = 1; samp = 1; b = (it - 256) >> 3; hh = it & 7; }
                else if (it < 448) { type = 2; samp = 1; b = (it - 384) >> 2; hh = it & 3; }
                else if (it < 512) { type = 0; samp = 1; b = (it - 448) >> 2; hh = it & 3; }
                else { const int q = it - 512, s = q % 96; qb = 7 - q / 96; if (s < 64) { type = 1; b = s >> 3; hh = s & 7; } else { type = 2; b = (s - 64) >> 2; hh = s & 3; } }
                const int kvbase = samp ? MP + b * KVS : b * 2048;
                const int qrow0 = samp ? MP + b * 64 : b * 2048 + 256 * qb;
                const int nq = samp ? 64 : 256;
                bf16_t* mixp = samp ? UP(U_UC) - (size_t)MP * 1024 : UP(U_MIX);
#ifndef NO_P5
                if (type == 1) {
                    const int w = tid >> 6;
                    mla_item(g_wave, lds, UP(U_QN), UP(U_QR), UP(U_KN), UP(U_KR), UP(U_VM), mixp, kvbase, qrow0, nq, hh, samp ? 17 : 4 * qb + 4, samp ? (w < 2 ? 17 : 0) : 4 * qb + (w >> 1) + 1);
                } else if (type == 2) {
                    sb_item(g_wave, lds, UP(U_SQ), samp ? out + O_SSK + ((size_t)l * MS + b * 64) * 256 : out + O_PSK + ((size_t)l * MP + b * 2048) * 256,
                            samp ? out + O_SSV + ((size_t)l * MS + b * 64) * 256 : out + O_PSV + ((size_t)l * MP + b * 2048) * 256, mixp, kvbase, qrow0, samp ? 1024 : 256 * qb, nq, hh,
                            samp ? PIN(I_CSK) + ((size_t)l * 16 + b) * 1024 * 256 : nullptr, samp ? PIN(I_CSV) + ((size_t)l * 16 + b) * 1024 * 256 : nullptr);
                } else {
                    const float* S0 = samp ? PIN(I_SRET) + ((size_t)(l * 16 + b) * 4 + hh) * 4096 : nullptr;
                    float* So = samp ? out + O_SS + ((size_t)(l * 16 + b) * 4 + hh) * 4096 : (grp == 7 ? out + O_PS + ((size_t)(l * 8 + b) * 4 + hh) * 4096 : nullptr);
#if RET_PAR
                    const float* UCb = samp ? nullptr : (const float*)(U + U_UC) + (size_t)((b * 4 + hh) * 32) * 4096;
                    ret_item(g_wave, lds, UP(U_RQ), UP(U_RK), UP(U_RV), UP(U_RG), PIN(I_GRET) + l * 256, mixp, samp ? MP + b * 64 : b * 2048 + 256 * grp, samp ? 1 : 4, hh, S0, So, UCb, 4 * grp);
#else
#ifndef REP_RET
#define REP_RET 1
#endif
                    for (int rr_ = 0; rr_ < REP_RET; ++rr_) {
                    ret_item(g_wave, lds, UP(U_RQ), UP(U_RK), UP(U_RV), UP(U_RG), PIN(I_GRET) + l * 256, mixp, samp ? MP + b * 64 : b * 2048, samp ? 1 : 32, hh, S0, So, nullptr, 0);
                    __syncthreads(); }
#endif
                }
#endif
            }
        }
        GSYNC();
#ifndef REP_P6
#define REP_P6 1
#endif
#ifndef REP_P9
#define REP_P9 1
#endif
        {
            PH_BEGIN
            unsigned* hand1 = WSP(unsigned, WS_CTL) + 3700 + 64 * l + 16;
            unsigned* hand2 = WSP(unsigned, WS_CTL) + 3700 + 64 * l + 32;
#define HAND_PUBLISH(p) do { asm volatile("s_waitcnt vmcnt(0)" ::: "memory"); __syncthreads(); \
                if (otid() == 0) { __builtin_amdgcn_fence(__ATOMIC_RELEASE, "agent"); asm volatile("s_waitcnt vmcnt(0)" ::: "memory"); (void)xb_add((p), 1u); } } while (0)
#define HAND_WAITN(p, n) do { if (otid() == 0) { unsigned sp_ = 0u; while (xb_ld(p) < (unsigned)(n)) { __builtin_amdgcn_s_sleep(2); if (++sp_ > (1u << 22)) break; } \
                __builtin_amdgcn_fence(__ATOMIC_ACQUIRE, "agent"); asm volatile("s_waitcnt vmcnt(0)" ::: "memory"); } __syncthreads(); } while (0)
            EpiRes e; e.xin_p = l == 0 ? PIN(I_XP) : out + O_YP; e.xin_s = l == 0 ? PIN(I_XS) : out + O_YS; e.xout = out; e.ws = ws; e.gate_off = l * 24 * 6144 + 2048;
            e.has_ap = 1; e.gn = PIN(I_GN2) + l * 1024; e.scn_off = l * 24 * 6144 + 4096;
            EpiUp eu; eu.l = l; eu.ws = ws; eu.out = out; eu.convw = PIN(I_CONVW); eu.convb = PIN(I_CONVB); eu.sconv = PIN(I_SCONV);
            const bf16_t* WOl = (const bf16_t*)(ws + WS_W + l * W_LAYER + W_O); const bf16_t* WUPl = (const bf16_t*)(ws + WS_W + l * W_LAYER + W_UP);
            run_gemm_sub(g_wave, lds, UP(U_MIX), WOl, MP, 1024, 1024, 0, G, bid, e);
            HAND_PUBLISH(hand1);
            if (bid < 16) {
                run_gemm_sub(g_wave, lds, UP(U_UC) - (size_t)MP * 1024, WOl, MS, 1024, 1024, 64, 16, bid, e);
                HAND_PUBLISH(hand2);
                HAND_WAITN(hand2, 16);
                run_gemm_win(g_wave, lds, UP(U_AP), WUPl, MS, NUP, 1024, 64, 16, bid, 0, 64, eu);
            } else {
                HAND_WAITN(hand1, G);
                run_gemm_sub(g_wave, lds, UP(U_AP), WUPl, MP, NUP, 1024, 0, G - 16, bid - 16, eu);
                if (bid >= G - 24) {
                    HAND_WAITN(hand2, 16);
                    run_gemm_win(g_wave, lds, UP(U_AP), WUPl, MS, NUP, 1024, 64, 24, bid - (G - 24), 64, 88, eu);
                }
            }
#undef HAND_PUBLISH
#undef HAND_WAITN
        }
        GSYNC();
        {
            PH_BEGIN
            EpiRes e; e.xin_p = out + O_YP; e.xin_s = out + O_YS; e.xout = out; e.ws = ws; e.gate_off = l * 24 * 6144 + 5120;
            e.has_ap = (l == 0); e.gn = PIN(I_GN1) + 1024; e.scn_off = 24 * 6144 + 1024;
            {
                pg8::StaticOrder So; So.init(MP, 1024, G, bid);
                pg8::Unit uu;
                bf16_t* B_ = UP(U_B);
                const float* HA = (const float*)(U + U_HA); const float* HB = (const float*)(U + U_HB); const float* TA = (const float*)(U + U_TA);
                const float* cw = PIN(I_CONVW) + (size_t)l * 3 * DFF; const float* cbp = PIN(I_CONVB) + (size_t)l * DFF;
                for (int iu = 0; So.next(iu, uu); ++iu) {
                    for (int task = tid; task < 4 * 2 * 352; task += 512) {
                        const int G64 = uu.pm * 4 + task / 704, rem = task % 704, rr = rem / 352, c = (rem % 352) * 8;
                        if ((G64 & 31) == 0) continue;
                        const float* t0 = TA + ((size_t)(G64 - 1) * 2) * DFF + c; const float* t1 = t0 + DFF;
                        const float* h0 = HA + ((size_t)G64 * 2) * DFF + c; const float* h1 = h0 + DFF;
                        const float* p2p = rr ? t1 : t0; const float* p1p = rr ? h0 : t1; const float* ap = rr ? h1 : h0;
                        const float* bp = HB + ((size_t)G64 * 2 + rr) * DFF + c;
                        float o[8];
#pragma unroll
                        for (int q = 0; q < 2; ++q) {
                            const f32x4 p2 = *(const f32x4*)(p2p + 4 * q), p1 = *(const f32x4*)(p1p + 4 * q), a = *(const f32x4*)(ap + 4 * q), b = *(const f32x4*)(bp + 4 * q);
                            const f32x4 w0 = *(const f32x4*)(cw + c + 4 * q), w1 = *(const f32x4*)(cw + DFF + c + 4 * q), w2 = *(const f32x4*)(cw + 2 * DFF + c + 4 * q), cb = *(const f32x4*)(cbp + c + 4 * q);
#pragma unroll
                            for (int j = 0; j < 4; ++j) o[4 * q + j] = silu(cb[j] + w0[j] * p2[j] + w1[j] * p1[j] + w2[j] * a[j]) * b[j];
                        }
                        *(u32x4*)(B_ + (size_t)(64 * G64 + rr) * DFF + c) = pack8(o);
                    }
                }
                asm volatile("s_waitcnt vmcnt(0)" ::: "memory");
                __syncthreads();
            }
            run_gemm_sub(g_wave, lds, UP(U_B), (const bf16_t*)(ws + WS_W + l * W_LAYER + W_DN), MP, 1024, DFF, 0, G, bid, e);
            if (l == 0) {
                for (int up = 0; up < 2; ++up) {
                    EpiC ec; ec.dst = up ? WSP(float, WS_CV2) + (size_t)24 * NUP : WSP(float, WS_CV1) + (size_t)24 * NIN; ec.r0 = 32 * (2 + up); ec.ldc = up ? NUP : NIN;
                    run_gemm_w(g_wave, lds, WSP(bf16_t, WS_SHM), (const bf16_t*)(ws + WS_W + W_LAYER + (up ? W_UP : W_IN)), 256, up ? NUP : NIN, 1024, G - (up ? 26 : 16), ec);
                }
            }
        }
        GSYNC();
        {
            PH_BEGIN
            unsigned* hand = WSP(unsigned, WS_CTL) + 3700 + 64 * l;
#define HAND_WAIT() do { if (otid() == 0) { unsigned sp_ = 0u; while (xb_ld(hand) < 16u) { __builtin_amdgcn_s_sleep(2); if (++sp_ > (1u << 22)) break; } \
                __builtin_amdgcn_fence(__ATOMIC_ACQUIRE, "agent"); asm volatile("s_waitcnt vmcnt(0)" ::: "memory"); } __syncthreads(); } while (0)
            if (bid < 16) {
                EpiRes e; e.xin_p = out + O_YP; e.xin_s = out + O_YS; e.xout = out; e.ws = ws; e.gate_off = l * 24 * 6144 + 5120;
                e.has_ap = (l == 0); e.gn = PIN(I_GN1) + 1024; e.scn_off = 24 * 6144 + 1024;
                run_gemm_sub(g_wave, lds, UP(U_B), (const bf16_t*)(ws + WS_W + l * W_LAYER + W_DN), MS, 1024, DFF, 64, 16, bid, e);
                asm volatile("s_waitcnt vmcnt(0)" ::: "memory");
                __syncthreads();
                if (otid() == 0) { __builtin_amdgcn_fence(__ATOMIC_RELEASE, "agent"); asm volatile("s_waitcnt vmcnt(0)" ::: "memory"); (void)xb_add(hand, 1u); }
            } else if (l == 0) {
                EpiIn e1; e1.l = 1; e1.ws = ws; e1.out = out; e1.gkv = PIN(I_GKV) + 256; e1.xl = lds + 131072;
                run_gemm_sub(g_wave, lds, UP(U_AP), (const bf16_t*)(ws + WS_W + W_LAYER + W_IN), MP, NIN, 1024, 0, G - 16, bid - 16, e1);
                if (bid >= G - 40) {
                    HAND_WAIT();
                    run_gemm_sub(g_wave, lds, UP(U_AP), (const bf16_t*)(ws + WS_W + W_LAYER + W_IN), MS, NIN, 1024, 64, 40, bid - (G - 40), e1);
                }
            } else {
                const float* SSQ = WSP(float, WS_SSQ);
                const int w = tid >> 6, lane = tid & 63;
                const float* gf = PIN(I_GFIN);
                for (int row = (bid - 16) * 8 + w; row < MP; row += (G - 16) * 8) {
                    const float rinv = rsqrtf(sum16(SSQ + (size_t)row * 16) * (1.f / 1024.f) + EPS);
                    float* xr = out + (size_t)row * 1024;
#pragma unroll
                    for (int q = 0; q < 4; ++q) {
                        const int c = q * 256 + lane * 4;
                        f32x4 x = *(f32x4*)(xr + c); const f32x4 g = *(const f32x4*)(gf + c);
                        x = x * g * rinv; *(f32x4*)(xr + c) = x;
                    }
                }
                if (bid < 16 + MS / 8) {
                    HAND_WAIT();
                    const int row = MP + (bid - 16) * 8 + w;
                    const float rinv = rsqrtf(sum16(SSQ + (size_t)row * 16) * (1.f / 1024.f) + EPS);
                    float* xr = out + (size_t)row * 1024;
#pragma unroll
                    for (int q = 0; q < 4; ++q) {
                        const int c = q * 256 + lane * 4;
                        f32x4 x = *(f32x4*)(xr + c); const f32x4 g = *(const f32x4*)(gf + c);
                        x = x * g * rinv; *(f32x4*)(xr + c) = x;
                    }
                }
            }
#undef HAND_WAIT
        }
        if (l == 0) GSYNC();
    }
}

extern "C" void kernel_launch(void* const* d_in, const int* in_sizes, int n_in, void* d_out, int out_size, void* d_ws, size_t ws_size, hipStream_t stream) {
    static int grid = 0;
    if (grid == 0) {
        if (n_in != 26 || (size_t)out_size != O_END || ws_size < WS_END) {
            fprintf(stderr, "kernel_launch: unexpected shapes: n_in %d out %d (want %zu) ws %zu (need %zu)\n", n_in, out_size, (size_t)O_END, ws_size, (size_t)WS_END);
            grid = -1; return;
        }
        int dev = 0, cus = 0, per_cu = 0;
        hipGetDevice(&dev);
        hipDeviceGetAttribute(&cus, hipDeviceAttributeMultiprocessorCount, dev);
        hipFuncSetAttribute((const void*)mega, hipFuncAttributeMaxDynamicSharedMemorySize, LDS_BYTES);
        hipOccupancyMaxActiveBlocksPerMultiprocessor(&per_cu, (const void*)mega, 512, LDS_BYTES);
        if (per_cu < 1) { fprintf(stderr, "kernel_launch: occupancy query says %d blocks/CU\n", per_cu); grid = -1; return; }
        grid = cus * 1;
    }
    if (grid < 0) return;
    (void)hipMemsetAsync((char*)d_ws + WS_CTL, 0, 16384, stream);
    Params p{};
    for (int i = 0; i < 26; ++i) p.in[i] = (const float*)d_in[i];
    p.out = (float*)d_out; p.ws = (unsigned char*)d_ws;
    void* args[] = {&p};
    hipError_t e = hipLaunchCooperativeKernel((const void*)mega, dim3(grid), dim3(512), args, LDS_BYTES, stream);
    if (e != hipSuccess) fprintf(stderr, "cooperative launch failed: %s (grid %d)\n", hipGetErrorString(e), grid);
}
```

```cpp
#include <hip/hip_runtime.h>
#include <hip/hip_cooperative_groups.h>
#include <cstdio>
#include <cstdint>
namespace cg = cooperative_groups;

#ifndef GEMM_ALIGN
#define GEMM_ALIGN true
#endif
#ifndef GEMM_SP2
#define GEMM_SP2 true
#endif
#ifndef RET_PAR
#define RET_PAR 0
#endif
#define DI __device__ __forceinline__
#define LAS __attribute__((address_space(3)))
#define GAS __attribute__((address_space(1)))
typedef unsigned short bf16_t;
typedef short bf16x8 __attribute__((ext_vector_type(8)));
typedef short s16x4 __attribute__((ext_vector_type(4)));
typedef float f32x4 __attribute__((ext_vector_type(4)));
typedef float f32x2 __attribute__((ext_vector_type(2)));
typedef float f32x16 __attribute__((ext_vector_type(16)));
typedef unsigned u32x4 __attribute__((ext_vector_type(4)));
typedef unsigned u32x2 __attribute__((ext_vector_type(2)));
typedef __bf16 bf16x2_t __attribute__((ext_vector_type(2)));

constexpr int MP = 16384, MS = 1024, MT = MP + MS, DM = 1024, KVS = 1088, KVR = MP + 16 * KVS, DFF = 2816;
constexpr int NIN = 2560, NUP = 5632;
constexpr float EPS = 1e-6f, LOG2E = 1.4426950408889634f, LN2 = 0.6931471805599453f;

constexpr size_t O_YP = 0, O_YS = O_YP + (size_t)MP * DM, O_PLAT = O_YS + (size_t)MS * DM, O_PKR = O_PLAT + (size_t)2 * MP * 256,
    O_PSK = O_PKR + (size_t)2 * MP * 32, O_PSV = O_PSK + (size_t)2 * MP * 256, O_PS = O_PSV + (size_t)2 * MP * 256,
    O_PCONV = O_PS + (size_t)2 * 8 * 4 * 64 * 64, O_SLAT = O_PCONV + (size_t)2 * 8 * 2 * DFF, O_SKR = O_SLAT + (size_t)2 * MS * 256,
    O_SSK = O_SKR + (size_t)2 * MS * 32, O_SSV = O_SSK + (size_t)2 * MS * 256, O_SS = O_SSV + (size_t)2 * MS * 256,
    O_SCONV = O_SS + (size_t)2 * 16 * 4 * 64 * 64, O_END = O_SCONV + (size_t)2 * 16 * 2 * DFF;

constexpr size_t al(size_t x) { return (x + 255) & ~(size_t)255; }
constexpr size_t WS_CTL = 0;
constexpr size_t WS_MOD = 16384;
constexpr size_t WS_CV1 = al(WS_MOD + (size_t)2 * 24 * 6144 * 4);
constexpr size_t WS_CV2 = al(WS_CV1 + (size_t)2 * 24 * NIN * 4);
constexpr size_t WS_SHM = al(WS_CV2 + (size_t)2 * 24 * NUP * 4);
constexpr size_t WS_SSQ = al(WS_SHM + (size_t)256 * 1024 * 2);
constexpr size_t WS_SSQQ = al(WS_SSQ + (size_t)MT * 16 * 4);
constexpr size_t WS_SSQKV = al(WS_SSQQ + (size_t)MT * 8 * 4);
constexpr size_t WS_W = al(WS_SSQKV + (size_t)MT * 4 * 4);
constexpr size_t W_IN = 0, W_UQ = W_IN + (size_t)NIN * 1024 * 2, W_UKVG = W_UQ + (size_t)768 * 384 * 2, W_UKV = W_UKVG + (size_t)1024 * 256 * 2,
    W_O = W_UKV + (size_t)1024 * 256 * 2, W_UP = W_O + (size_t)1024 * 1024 * 2, W_DN = W_UP + (size_t)NUP * 1024 * 2, W_LAYER = W_DN + (size_t)1024 * DFF * 2;
constexpr size_t WS_CLB = al(WS_W + 2 * W_LAYER);
constexpr size_t WS_U = al(WS_CLB + (size_t)2 * 16384 * 256 * 2);
constexpr size_t U_ZQ = 0, U_ZKV = al(U_ZQ + (size_t)MT * 384 * 2), U_KR = al(U_ZKV + (size_t)MT * 256 * 2), U_SK = al(U_KR + (size_t)KVR * 32 * 2),
    U_SV = al(U_SK + (size_t)KVR * 256 * 2), U_RQ = al(U_SV + (size_t)KVR * 256 * 2), U_RK = al(U_RQ + (size_t)MT * 256 * 2), U_RV = al(U_RK + (size_t)MT * 256 * 2),
    U_RG = al(U_RV + (size_t)MT * 256 * 2), U_SQ = al(U_RG + (size_t)MT * 256 * 2), U_MIX = al(U_SQ + (size_t)MT * 256 * 2), U_QN = al(U_MIX + (size_t)MT * 1024 * 2),
    U_QR = al(U_QN + (size_t)MT * 512 * 2), U_KN = al(U_QR + (size_t)MT * 256 * 2), U_VM = al(U_KN + (size_t)KVR * 512 * 2), U_ATT_END = al(U_VM + (size_t)KVR * 512 * 2);
constexpr size_t U_A = 0, U_B = al(U_A + (size_t)MT * DFF * 2), U_FFN_END = al(U_B + (size_t)MT * DFF * 2);
constexpr size_t U_AP = U_FFN_END > U_QN ? U_FFN_END : U_QN;
constexpr size_t U_AP_END = U_AP + (size_t)MT * 1024 * 2;
static_assert(U_AP >= U_QN && U_AP >= U_FFN_END, "AP placement");
constexpr size_t U_UC = al(U_AP_END > U_ATT_END ? U_AP_END : U_ATT_END);
constexpr size_t WS_END = WS_U + U_UC + (size_t)1024 * 4096 * 4;

constexpr int LDS_BYTES = 147456;
constexpr int LDS_MISC = 147456 - 64;

struct Params {
    const float* in[26];
    float* out;
    unsigned char* ws;
};
enum { I_XP = 0, I_XS, I_CP, I_CS, I_CLAT, I_CKR, I_CSK, I_CSV, I_SRET, I_SCONV, I_WIN, I_GQ, I_WUQ, I_GKV, I_WUKV, I_GRET, I_WO, I_WUP, I_CONVW, I_CONVB,
       I_WDN, I_GN1, I_GN2, I_WADA, I_BADA, I_GFIN };

DI unsigned pk2(float lo, float hi) { f32x2 v = {lo, hi}; bf16x2_t b = __builtin_convertvector(v, bf16x2_t); return __builtin_bit_cast(unsigned, b); }
DI float bf2f(unsigned short b) { return __builtin_bit_cast(float, (unsigned)b << 16); }
DI float bflo(unsigned u) { return __builtin_bit_cast(float, u << 16); }
DI float bfhi(unsigned u) { return __builtin_bit_cast(float, u & 0xffff0000u); }
DI u32x4 pack8(const float* v) { u32x4 w; w.x = pk2(v[0], v[1]); w.y = pk2(v[2], v[3]); w.z = pk2(v[4], v[5]); w.w = pk2(v[6], v[7]); return w; }
DI u32x2 pack4(const float* v) { u32x2 w; w.x = pk2(v[0], v[1]); w.y = pk2(v[2], v[3]); return w; }
DI float ex2(float x) { return __builtin_amdgcn_exp2f(x); }
DI float lg2(float x) { return __builtin_amdgcn_logf(x); }
DI float silu(float x) { return x * __builtin_amdgcn_rcpf(1.f + ex2(-x * LOG2E)); }
DI void sincos_rev(float ang, float& s, float& c) { float rev = ang * 0.15915494309189535f; rev = __builtin_amdgcn_fractf(rev); s = __builtin_amdgcn_sinf(rev); c = __builtin_amdgcn_cosf(rev); }
DI void row_info(int row, int& mb, int& pos, int& kvrow) {
    if (row < MP) { mb = row >> 11; pos = row & 2047; kvrow = row; }
    else { const int r = row - MP, b = r >> 6, t = r & 63; mb = 8 + b; pos = 1024 + t; kvrow = MP + b * KVS + 1024 + t; }
}
DI float* orow(float* out, int l, int row, size_t poff, size_t soff, int W) {
    return row < MP ? out + poff + ((size_t)l * MP + row) * W : out + soff + ((size_t)l * MS + (row - MP)) * W;
}
DI float sum16(const float* p) { const f32x4* q = (const f32x4*)p; f32x4 a = q[0], b = q[1], c = q[2], d = q[3]; f32x4 s = (a + b) + (c + d); return (s[0] + s[1]) + (s[2] + s[3]); }
DI float sum8(const float* p) { const f32x4* q = (const f32x4*)p; f32x4 s = q[0] + q[1]; return (s[0] + s[1]) + (s[2] + s[3]); }
DI float sum4(const float* p) { const f32x4 s = *(const f32x4*)p; return (s[0] + s[1]) + (s[2] + s[3]); }
DI float shx(float v, int lane, int m) { return __builtin_bit_cast(float, __builtin_amdgcn_ds_bpermute((lane ^ m) << 2, __builtin_bit_cast(int, v))); }
#define xor16_32(s) xor16_32_l((s), fr + 16 * fq)
DI float xor16_32_l(float s, int lane) { s += shx(s, lane, 16); s += shx(s, lane, 32); return s; }
DI int otid_w(int wave) { int lane; asm volatile("v_mbcnt_lo_u32_b32 %0, -1, 0\n\tv_mbcnt_hi_u32_b32 %0, -1, %0" : "=v"(lane)); asm volatile("" : "+s"(wave)); return wave * 64 + lane; }
#define otid() otid_w(g_wave)
template <class T> DI T* osp(T* p) { GAS T* g = (GAS T*)p; asm volatile("" : "+s"(g)); return (T*)g; }
template <class T> DI T* gptr(T* p) { return p; }
DI int osi(int v) { asm volatile("" : "+s"(v)); return v; }
DI int crow(int i, int h) { return (i & 3) + 8 * (i >> 2) + 4 * h; }
#define LBAR() do { asm volatile("s_waitcnt lgkmcnt(0)" ::: "memory"); __builtin_amdgcn_s_barrier(); asm volatile("" ::: "memory"); } while (0)
#define MFMA32(a, b, c) __builtin_amdgcn_mfma_f32_32x32x16_bf16((a), (b), (c), 0, 0, 0)
typedef short v4i16_t __attribute__((ext_vector_type(4)));
DI s16x4 trr(LAS const unsigned char* p) { return __builtin_bit_cast(s16x4, __builtin_amdgcn_ds_read_tr16_b64_v4i16((LAS v4i16_t*)p)); }
DI bf16x8 tr_frag(LAS const unsigned char* p, int hi_off) { s16x4 lo = trr(p), hi = trr(p + hi_off); return __builtin_shufflevector(lo, hi, 0, 1, 2, 3, 4, 5, 6, 7); }
DI bf16x8 packfrag(const f32x16& x, int s) {
    u32x4 w; w.x = pk2(x[8 * s], x[8 * s + 1]); w.y = pk2(x[8 * s + 2], x[8 * s + 3]); w.z = pk2(x[8 * s + 4], x[8 * s + 5]); w.w = pk2(x[8 * s + 6], x[8 * s + 7]);
    return __builtin_bit_cast(bf16x8, w);
}

namespace pg8 {
constexpr int BM = 256, BK = 64, HALF = 128, HTB = HALF * BK * 2, STAGE_BYTES = 8 * HTB, NXCD = 8, WGM = 8;
DI int lds_byte(int r, int c) { const int st = (r >> 4) * 2 + (c >> 5), rr = r & 15, cc = c & 31, ob = rr * 64 + cc * 2; return st * 1024 + (ob ^ (((ob >> 9) & 1) << 5)); }
DI void stage_rc(int b, int& R, int& C) { const int st = b / 1024, sb = b % 1024, swz = sb ^ (((sb >> 9) & 1) << 5); R = (st >> 1) * 16 + swz / 64; C = (st & 1) * 32 + (swz % 64) / 2; }
DI int perm32(int rho) { const int n = rho >> 4, i = rho & 15; return 8 * (i >> 2) + 4 * n + (i & 3); }
struct Unit { int pm, pn; };
struct Gemm { const bf16_t* A; const bf16_t* Bt; int M, N, K; };
struct StaticOrder {
    int nM, nN, nwg, G, c, pm0, Llo, Lhi;
    DI void init(int M, int N, int G_, int c_) { nM = M / BM; nN = N / BM; nwg = nM * nN; G = G_; c = c_; pm0 = 0; Llo = 0; Lhi = nwg; }
    DI bool next(int i, Unit& u) const {
        int cc = c; asm volatile("" : "+s"(cc)); const long L = (long)Llo + (long)i * G + cc; if (L >= Lhi) return false;
        int wgid = (int)L; { const int q = nwg / NXCD, r = nwg % NXCD, xcd = wgid % NXCD, off = wgid / NXCD; wgid = (xcd < r ? xcd * (q + 1) : r * (q + 1) + (xcd - r) * q) + off; }
        const int nig = WGM * nN, gid = wgid / nig, fm = gid * WGM, gsz = (nM - fm) < WGM ? (nM - fm) : WGM;
        u.pm = pm0 + fm + ((wgid % nig) % gsz); u.pn = (wgid % nig) / gsz; return true;
    }
};

template <class Epi, bool ALIGN_EPI, bool SP2>
DI void gemm_phase(int g_wave, LAS unsigned char* lds, const Gemm g, const StaticOrder& S, const Epi& E) {
    const int tid = otid(), wid = __builtin_amdgcn_readfirstlane(tid >> 6), lane = tid & 63, wr = wid >> 2, wc = wid & 3, fr = lane & 15, fq = lane >> 4;
    const int K = g.K, nt = K / BK;
    unsigned voffA[2], voffB[2];
#pragma unroll
    for (int i = 0; i < 2; ++i) { int R, C; stage_rc(tid * 16 + i * 8192, R, C); const int Rb = (R & ~31) + perm32(R & 31);
        voffA[i] = (unsigned)(R * K + C) * 2u; voffB[i] = (unsigned)(Rb * K + C) * 2u; }
    const size_t kstep = (size_t)(BK * 2);
    const size_t hstep = (size_t)HALF * K * 2;
    const size_t tstep = 2 * hstep;
    const unsigned ldsw = (unsigned)wid * 1024u;
    const int aoff = lds_byte(wr * 64 + fr, fq * 8), boff = lds_byte(wc * 32 + fr, fq * 8);
#define PG8_SA(b, h) (((b) * 2 + (h)) * HTB)
#define PG8_SB(b, h) ((4 + (b) * 2 + (h)) * HTB)
#define PG8_STAGE(bufoff, gbase, voff) do { _Pragma("unroll") for (int _i = 0; _i < 2; ++_i) \
        __builtin_amdgcn_global_load_lds((const unsigned*)((const char*)(gbase) + (voff)[_i]), (LAS unsigned*)(lds + (bufoff) + ldsw + _i * 8192), 16, 0, 0); } while (0)
#define PG8_LDA(dst, b, h) do { _Pragma("unroll") for (int m = 0; m < 4; ++m) _Pragma("unroll") for (int k = 0; k < 2; ++k) dst[m][k] = *(const LAS bf16x8*)(lds + PG8_SA(b, h) + aoff + m * 2048 + k * 1024); } while (0)
#define PG8_LDB(dst, b, h) do { _Pragma("unroll") for (int n = 0; n < 2; ++n) _Pragma("unroll") for (int k = 0; k < 2; ++k) dst[n][k] = *(const LAS bf16x8*)(lds + PG8_SB(b, h) + boff + n * 2048 + k * 1024); } while (0)
#define PG8_MMA(ai, bj, At, Bt) do { __builtin_amdgcn_s_setprio(1); _Pragma("unroll") for (int m = 0; m < 4; ++m) _Pragma("unroll") for (int n = 0; n < 2; ++n) _Pragma("unroll") for (int k = 0; k < 2; ++k) \
        acc[ai][bj][m][n] = __builtin_amdgcn_mfma_f32_16x16x32_bf16(Bt[n][k], At[m][k], acc[ai][bj][m][n], 0, 0, 0); __builtin_amdgcn_s_setprio(0); } while (0)
#define PG8_WAIT_V(n) asm volatile("s_waitcnt vmcnt(" #n ")" ::: "memory")
#define PG8_WAIT_L(n) asm volatile("s_waitcnt lgkmcnt(" #n ")" ::: "memory")
#define PG8_BAR __builtin_amdgcn_s_barrier()
#define PG8_SCHED __builtin_amdgcn_sched_barrier(0)
    Unit cur, nxt; int ui = 0;
    if (!S.next(0, cur)) return;
    f32x4 acc[2][2][4][2];
#pragma unroll
    for (int a = 0; a < 2; ++a)
#pragma unroll
        for (int b = 0; b < 2; ++b)
#pragma unroll
            for (int m = 0; m < 4; ++m)
#pragma unroll
                for (int n = 0; n < 2; ++n) acc[a][b][m][n] = (f32x4){0.f, 0.f, 0.f, 0.f};
    bf16x8 At[4][2], B0[2][2], B1[2][2];
    const char* cA = (const char*)g.A + (size_t)cur.pm * tstep; const char* cB = (const char*)g.Bt + (size_t)cur.pn * tstep;
    if constexpr (SP2) {
        PG8_STAGE(PG8_SB(0, 0), cB, voffB); PG8_STAGE(PG8_SB(0, 1), cB + hstep, voffB); PG8_STAGE(PG8_SA(0, 0), cA, voffA); PG8_STAGE(PG8_SA(0, 1), cA + hstep, voffA);
        if (wr == 1) PG8_BAR;
        PG8_WAIT_V(2); PG8_BAR;
        PG8_STAGE(PG8_SB(1, 0), cB + kstep, voffB); PG8_STAGE(PG8_SA(1, 0), cA + kstep, voffA); PG8_STAGE(PG8_SB(1, 1), cB + hstep + kstep, voffB);
        PG8_WAIT_V(6); PG8_BAR;
    } else {
    PG8_STAGE(PG8_SB(0, 0), cB, voffB); PG8_STAGE(PG8_SA(0, 0), cA, voffA); PG8_STAGE(PG8_SB(0, 1), cB + hstep, voffB); PG8_STAGE(PG8_SA(0, 1), cA + hstep, voffA);
    if (wr == 1) PG8_BAR;
    PG8_WAIT_V(4); PG8_BAR;
    PG8_STAGE(PG8_SB(1, 0), cB + kstep, voffB); PG8_STAGE(PG8_SA(1, 0), cA + kstep, voffA); PG8_STAGE(PG8_SB(1, 1), cB + hstep + kstep, voffB);
    PG8_WAIT_V(6); PG8_BAR;
    }
    for (;;) {
        const bool has_next = S.next(ui + 1, nxt);
        const char* nA = has_next ? (const char*)g.A + (size_t)nxt.pm * tstep : cA; const char* nB = has_next ? (const char*)g.Bt + (size_t)nxt.pn * tstep : cB;
        for (int t = 0; t < nt; t += 2) {
            const bool last = (t == nt - 2);
            const char* a1 = cA + (size_t)(t + 1) * kstep;
            const char* a2 = last ? nA : cA + (size_t)(t + 2) * kstep; const char* b2 = last ? nB : cB + (size_t)(t + 2) * kstep;
            const char* a3 = a2 + kstep; const char* b3 = b2 + kstep;
            if constexpr (SP2) {
            PG8_LDB(B0, 0, 0); PG8_LDB(B1, 0, 1); PG8_SCHED; PG8_LDA(At, 0, 0); PG8_STAGE(PG8_SA(1, 1), a1 + hstep, voffA);
            PG8_WAIT_V(8); PG8_WAIT_L(0); PG8_BAR; PG8_MMA(0, 0, At, B0); PG8_MMA(0, 1, At, B1); PG8_BAR; PG8_SCHED;
            PG8_LDA(At, 0, 1); PG8_STAGE(PG8_SB(0, 0), b2, voffB); PG8_STAGE(PG8_SB(0, 1), b2 + hstep, voffB); PG8_STAGE(PG8_SA(0, 0), a2, voffA);
            PG8_WAIT_V(8); PG8_WAIT_L(0); PG8_BAR; PG8_MMA(1, 0, At, B0); PG8_MMA(1, 1, At, B1); PG8_BAR; PG8_SCHED;
            PG8_LDB(B0, 1, 0); PG8_LDB(B1, 1, 1); PG8_SCHED; PG8_LDA(At, 1, 0); PG8_STAGE(PG8_SA(0, 1), a2 + hstep, voffA);
            PG8_WAIT_V(8); PG8_WAIT_L(0); PG8_BAR; PG8_MMA(0, 0, At, B0); PG8_MMA(0, 1, At, B1); PG8_BAR; PG8_SCHED;
            PG8_LDA(At, 1, 1); PG8_STAGE(PG8_SB(1, 0), b3, voffB); PG8_STAGE(PG8_SB(1, 1), b3 + hstep, voffB); PG8_STAGE(PG8_SA(1, 0), a3, voffA);
            PG8_WAIT_V(8); PG8_WAIT_L(0); PG8_BAR; PG8_MMA(1, 0, At, B0); PG8_MMA(1, 1, At, B1); PG8_BAR; PG8_SCHED;

            } else {
            PG8_LDB(B0, 0, 0); PG8_SCHED; PG8_LDA(At, 0, 0); PG8_STAGE(PG8_SA(1, 1), a1 + hstep, voffA);
            PG8_WAIT_L(8); PG8_BAR; PG8_WAIT_L(0); PG8_MMA(0, 0, At, B0); PG8_BAR; PG8_SCHED;
            PG8_LDB(B1, 0, 1); PG8_STAGE(PG8_SB(0, 0), b2, voffB);
            PG8_BAR; PG8_WAIT_L(0); PG8_MMA(0, 1, At, B1); PG8_BAR;
            PG8_LDA(At, 0, 1); PG8_STAGE(PG8_SA(0, 0), a2, voffA);
            PG8_BAR; PG8_WAIT_L(0); PG8_MMA(1, 0, At, B0); PG8_BAR; PG8_SCHED;
            PG8_STAGE(PG8_SB(0, 1), b2 + hstep, voffB);
            PG8_WAIT_V(6); PG8_BAR; PG8_MMA(1, 1, At, B1); PG8_BAR;
            PG8_LDB(B0, 1, 0); PG8_SCHED; PG8_LDA(At, 1, 0); PG8_STAGE(PG8_SA(0, 1), a2 + hstep, voffA);
            PG8_WAIT_L(8); PG8_BAR; PG8_WAIT_L(0); PG8_MMA(0, 0, At, B0); PG8_BAR; PG8_SCHED;
            PG8_LDB(B1, 1, 1); PG8_STAGE(PG8_SB(1, 0), b3, voffB);
            PG8_BAR; PG8_WAIT_L(0); PG8_MMA(0, 1, At, B1); PG8_BAR;
            PG8_LDA(At, 1, 1); PG8_STAGE(PG8_SA(1, 0), a3, voffA);
            PG8_BAR; PG8_WAIT_L(0); PG8_MMA(1, 0, At, B0); PG8_BAR; PG8_SCHED;
            PG8_STAGE(PG8_SB(1, 1), b3 + hstep, voffB);
            PG8_WAIT_V(6); PG8_BAR; PG8_MMA(1, 1, At, B1); PG8_BAR;
            }
        }
        if constexpr (ALIGN_EPI) { if (wr == 0) PG8_BAR; }
        { const int t2_ = otid(); int fr_ = t2_ & 15, fq_ = (t2_ >> 4) & 3, wr_ = wr, wc_ = wc; asm volatile("" : "+v"(fr_), "+v"(fq_), "+s"(wr_), "+s"(wc_)); E(acc, cur, wr_, wc_, fr_, fq_); }
        if (!has_next) break;
#pragma unroll
        for (int a = 0; a < 2; ++a)
#pragma unroll
            for (int b = 0; b < 2; ++b)
#pragma unroll
                for (int m = 0; m < 4; ++m)
#pragma unroll
                    for (int n = 0; n < 2; ++n) acc[a][b][m][n] = (f32x4){0.f, 0.f, 0.f, 0.f};
        cur = nxt; cA = nA; cB = nB; ++ui;
        if constexpr (ALIGN_EPI) { if (wr == 1) PG8_BAR; }
    }
    PG8_WAIT_V(0);
    if constexpr (!ALIGN_EPI) { if (wr == 0) PG8_BAR; }
    PG8_BAR;
#undef PG8_SA
#undef PG8_SB
#undef PG8_STAGE
#undef PG8_LDA
#undef PG8_LDB
#undef PG8_MMA
#undef PG8_WAIT_V
#undef PG8_WAIT_L
#undef PG8_BAR
#undef PG8_SCHED
}
}
using pg8::Unit;
typedef const f32x4 (&AccRef)[2][2][4][2];

template <class Epi>
DI void run_gemm_w(int g_wave, LAS unsigned char* lds, const bf16_t* A, const bf16_t* Bt, int M, int N, int K, int rot, const Epi& E) {
    pg8::Gemm g; g.A = A; g.Bt = Bt; g.M = M; g.N = N; g.K = K;
    pg8::StaticOrder S; S.init(M, N, gridDim.x, (int)((blockIdx.x + (unsigned)rot) % gridDim.x));
    pg8::gemm_phase<Epi, GEMM_ALIGN, GEMM_SP2>(g_wave, lds, g, S, E);
}

template <class Epi>
DI void run_gemm_sub(int g_wave, LAS unsigned char* lds, const bf16_t* A, const bf16_t* Bt, int M, int N, int K, int pm0, int Gs, int cs, const Epi& E) {
    pg8::Gemm g; g.A = A; g.Bt = Bt; g.M = M; g.N = N; g.K = K;
    pg8::StaticOrder S; S.init(M, N, Gs, cs); S.pm0 = pm0;
    pg8::gemm_phase<Epi, GEMM_ALIGN, GEMM_SP2>(g_wave, lds, g, S, E);
}

template <class Epi>
DI void run_gemm_win(int g_wave, LAS unsigned char* lds, const bf16_t* A, const bf16_t* Bt, int M, int N, int K, int pm0, int Gs, int cs, int lo, int hi, const Epi& E) {
    pg8::Gemm g; g.A = A; g.Bt = Bt; g.M = M; g.N = N; g.K = K;
    pg8::StaticOrder S; S.init(M, N, Gs, cs); S.pm0 = pm0; S.Llo = lo; S.Lhi = hi;
    pg8::gemm_phase<Epi, GEMM_ALIGN, GEMM_SP2>(g_wave, lds, g, S, E);
}

constexpr float KEXP32 = 13.287712379549449f / 16.f, KEXP64 = 13.287712379549449f / 32.f;

struct EpiC {
    float* dst; int r0, ldc;
    DI void operator()(AccRef acc, const Unit& u, int wr, int wc, int fr, int fq) const {
#pragma unroll
        for (int ai = 0; ai < 2; ++ai)
#pragma unroll
            for (int m = 0; m < 4; ++m) {
                const int row = ai * 128 + wr * 64 + 16 * m + fr - r0;
                if (row >= 0 && row < 24) {
#pragma unroll
                    for (int bj = 0; bj < 2; ++bj)
#pragma unroll
                        for (int n = 0; n < 2; ++n) *(f32x4*)(dst + (size_t)row * ldc + u.pn * 256 + bj * 128 + wc * 32 + fq * 8 + 4 * n) = acc[ai][bj][m][n];
                }
            }
    }
};

struct EpiIn {
    int l; unsigned char* ws; float* out; const float* gkv; LAS unsigned char* xl;
    template <int PN> DI void body(AccRef acc, const Unit& u, int wr, int wc, int fr, int fq) const {
        const int cl = wc * 32 + fq * 8;
        unsigned char* U = ws + WS_U;
        const float* ssq = (const float*)(ws + WS_SSQ); const float* cv = (const float*)(ws + WS_CV1) + (size_t)l * 24 * NIN;
        bf16_t *zq = (bf16_t*)(U + U_ZQ), *zkv = (bf16_t*)(U + U_ZKV), *kr = (bf16_t*)(U + U_KR), *sk = (bf16_t*)(U + U_SK), *sv = (bf16_t*)(U + U_SV), *rq = (bf16_t*)(U + U_RQ),
               *rk = (bf16_t*)(U + U_RK), *rv = (bf16_t*)(U + U_RV), *rg = (bf16_t*)(U + U_RG), *sq = (bf16_t*)(U + U_SQ);
        float *ssqq = (float*)(ws + WS_SSQQ), *ssqkv = (float*)(ws + WS_SSQKV);
        (void)zq; (void)zkv; (void)kr; (void)sk; (void)sv; (void)rq; (void)rk; (void)rv; (void)rg; (void)sq; (void)ssqq; (void)ssqkv;
        float rinvh[2][4];
        f32x4 cvh[2][2][2];
        int zdep = 0;
#pragma unroll
        for (int ai = 0; ai < 2; ++ai) {
            const int rb_ = u.pm * 256 + ai * 128 + wr * 64 + fr;
#pragma unroll
            for (int m = 0; m < 4; ++m) rinvh[ai][m] = rsqrtf(sum16(ssq + (size_t)(rb_ + 16 * m + zdep) * 16) * (1.f / 1024.f) + EPS);
            asm volatile("v_mov_b32 %0, 0" : "=v"(zdep) : "v"(rinvh[ai][0]), "v"(rinvh[ai][1]), "v"(rinvh[ai][2]), "v"(rinvh[ai][3]));
        }
#pragma unroll
        for (int ai = 0; ai < 2; ++ai) {
            const int rb_ = u.pm * 256 + ai * 128 + wr * 64 + fr;
            int mb_, p_, k_; row_info(rb_, mb_, p_, k_);
#pragma unroll
            for (int bj = 0; bj < 2; ++bj)
#pragma unroll
                for (int n = 0; n < 2; ++n) cvh[ai][bj][n] = *(const f32x4*)(cv + (size_t)(mb_ + zdep) * NIN + PN * 256 + bj * 128 + cl + 4 * n);
        }
#pragma unroll
        for (int ai = 0; ai < 2; ++ai) {
            const int rb = u.pm * 256 + ai * 128 + wr * 64 + fr;
            int mb, pos0, kv0; row_info(rb, mb, pos0, kv0);
#pragma unroll
            for (int m = 0; m < 4; ++m) {
                const int row = rb + 16 * m, pos = pos0 + 16 * m, kvrow = kv0 + 16 * m;
                const float rinv = rinvh[ai][m];
                float v[2][8];
#pragma unroll
                for (int bj = 0; bj < 2; ++bj)
#pragma unroll
                    for (int n = 0; n < 2; ++n)
#pragma unroll
                        for (int j = 0; j < 4; ++j) v[bj][4 * n + j] = acc[ai][bj][m][n][j] * rinv + cvh[ai][bj][n][j];
                if constexpr (PN == 0) {
                    float s = 0.f;
#pragma unroll
                    for (int bj = 0; bj < 2; ++bj) {
                        *(u32x4*)(zkv + (size_t)row * 256 + bj * 128 + cl) = pack8(v[bj]);
#pragma unroll
                        for (int j = 0; j < 8; ++j) s += v[bj][j] * v[bj][j];
                    }
                    s = xor16_32(s);
                    if (fq == 0) { ssqkv[(size_t)row * 4 + wc] = s; *(LAS float*)(xl + ((ai * 128 + wr * 64 + 16 * m + fr) * 4 + wc) * 4) = s; }
                } else if constexpr (PN == 1) {
                    float s = 0.f;
#pragma unroll
                    for (int bj = 0; bj < 2; ++bj) {
                        *(u32x4*)(zq + (size_t)row * 384 + bj * 128 + cl) = pack8(v[bj]);
#pragma unroll
                        for (int j = 0; j < 8; ++j) s += v[bj][j] * v[bj][j];
                    }
                    s = xor16_32(s);
                    if (fq == 0) ssqq[(size_t)row * 8 + wc] = s;
                } else if constexpr (PN == 2) {
                    float s = 0.f;
                    *(u32x4*)(zq + (size_t)row * 384 + 256 + cl) = pack8(v[0]);
#pragma unroll
                    for (int j = 0; j < 8; ++j) s += v[0][j] * v[0][j];
                    s = xor16_32(s);
                    if (fq == 0) ssqq[(size_t)row * 8 + 4 + wc] = s;
                    if (wc == 0) {
                        float o1[4], o2[4];
#pragma unroll
                        for (int j = 0; j < 4; ++j) { const int i = 4 * fq + j; float sn, cs; sincos_rev((float)pos * ex2(-(float)i * KEXP32), sn, cs);
                            o1[j] = v[1][j] * cs - v[1][4 + j] * sn; o2[j] = v[1][j] * sn + v[1][4 + j] * cs; }
                        float* ko = orow(out, l, row, O_PKR, O_SKR, 32);
                        *(f32x4*)(ko + 4 * fq) = (f32x4){o1[0], o1[1], o1[2], o1[3]};
                        *(f32x4*)(ko + 16 + 4 * fq) = (f32x4){o2[0], o2[1], o2[2], o2[3]};
                        *(u32x2*)(kr + (size_t)kvrow * 32 + 4 * fq) = pack4(o1);
                        *(u32x2*)(kr + (size_t)kvrow * 32 + 16 + 4 * fq) = pack4(o2);
                    }
                } else if constexpr (PN == 3 || PN == 4) {
                    bf16_t* dst = PN == 3 ? rq : rk;
                    const float sc = PN == 3 ? 0.125f : 1.f;
#pragma unroll
                    for (int bj = 0; bj < 2; ++bj) {
                        const int head = 2 * bj + (wc >> 1), i0 = 16 * (wc & 1) + 4 * fq;
                        float o1[4], o2[4];
#pragma unroll
                        for (int j = 0; j < 4; ++j) { float sn, cs; sincos_rev((float)pos * ex2(-(float)(i0 + j) * KEXP64), sn, cs);
                            o1[j] = (v[bj][j] * cs - v[bj][4 + j] * sn) * sc; o2[j] = (v[bj][j] * sn + v[bj][4 + j] * cs) * sc; }
                        *(u32x2*)(dst + (size_t)row * 256 + head * 64 + i0) = pack4(o1);
                        *(u32x2*)(dst + (size_t)row * 256 + head * 64 + 32 + i0) = pack4(o2);
                    }
                } else if constexpr (PN == 5 || PN == 6 || PN == 7) {
                    bf16_t* dst = PN == 5 ? rv : (PN == 6 ? rg : sq);
#pragma unroll
                    for (int bj = 0; bj < 2; ++bj) {
                        if constexpr (PN == 6) {
#pragma unroll
                            for (int j = 0; j < 8; ++j) v[bj][j] = silu(v[bj][j]);
                        }
                        if constexpr (PN == 7) {
#pragma unroll
                            for (int j = 0; j < 8; ++j) v[bj][j] *= 0.125f;
                        }
                        *(u32x4*)(dst + (size_t)row * 256 + bj * 128 + cl) = pack8(v[bj]);
                    }
                } else {
                    float* lo = orow(out, l, row, PN == 8 ? O_PSK : O_PSV, PN == 8 ? O_SSK : O_SSV, 256);
#pragma unroll
                    for (int bj = 0; bj < 2; ++bj) {
                        *(f32x4*)(lo + bj * 128 + cl) = (f32x4){v[bj][0], v[bj][1], v[bj][2], v[bj][3]};
                        *(f32x4*)(lo + bj * 128 + cl + 4) = (f32x4){v[bj][4], v[bj][5], v[bj][6], v[bj][7]};
                    }
                }
            }
        }
        if constexpr (PN == 0) {
            static_assert(GEMM_ALIGN, "the exchange uses a workgroup barrier: both half-workgroups must be in the epilogue together");
            asm volatile("s_waitcnt lgkmcnt(0)" ::: "memory"); __builtin_amdgcn_s_barrier(); asm volatile("" ::: "memory");
            f32x4 gk[2][2];
#pragma unroll
            for (int bj = 0; bj < 2; ++bj)
#pragma unroll
                for (int n = 0; n < 2; ++n) gk[bj][n] = *(const f32x4*)(gkv + bj * 128 + cl + 4 * n);
#pragma unroll
            for (int ai = 0; ai < 2; ++ai) {
                const int rb = u.pm * 256 + ai * 128 + wr * 64 + fr;
#pragma unroll
                for (int m = 0; m < 4; ++m) {
                    const int row = rb + 16 * m;
                    const f32x4 pp = *(LAS const f32x4*)(xl + (ai * 128 + wr * 64 + 16 * m + fr) * 16);
                    const float rk = rsqrtf(((pp[0] + pp[1]) + (pp[2] + pp[3])) * (1.f / 256.f) + EPS);
                    float* lo = orow(out, l, row, O_PLAT, O_SLAT, 256);
#pragma unroll
                    for (int bj = 0; bj < 2; ++bj)
#pragma unroll
                        for (int n = 0; n < 2; ++n) {
                            const f32x4 vv = (acc[ai][bj][m][n] * rinvh[ai][m] + cvh[ai][bj][n]) * gk[bj][n] * rk;
                            *(f32x4*)(lo + bj * 128 + cl + 4 * n) = vv;
                        }
                }
            }
        }
    }
    DI void operator()(AccRef acc, const Unit& u, int wr, int wc, int fr, int fq) const {
        switch (u.pn) {
            case 0: body<0>(acc, u, wr, wc, fr, fq); break;
            case 1: body<1>(acc, u, wr, wc, fr, fq); break;
            case 2: body<2>(acc, u, wr, wc, fr, fq); break;
            case 3: body<3>(acc, u, wr, wc, fr, fq); break;
            case 4: body<4>(acc, u, wr, wc, fr, fq); break;
            case 5: body<5>(acc, u, wr, wc, fr, fq); break;
            case 6: body<6>(acc, u, wr, wc, fr, fq); break;
            case 7: body<7>(acc, u, wr, wc, fr, fq); break;
            case 8: body<8>(acc, u, wr, wc, fr, fq); break;
            default: body<9>(acc, u, wr, wc, fr, fq); break;
        }
    }
};

struct EpiQ {
    unsigned char* ws;
    DI void operator()(AccRef acc, const Unit& u, int wr, int wc, int fr, int fq) const {
        const int cl = wc * 32 + fq * 8;
        const float* ssqq = (const float*)(ws + WS_SSQQ); bf16_t *qn = (bf16_t*)(ws + WS_U + U_QN), *qr = (bf16_t*)(ws + WS_U + U_QR);
        const float qs = 0.10206207261596575f * LOG2E;
        float rinvh[2][4];
        int zdep = 0;
#pragma unroll
        for (int ai = 0; ai < 2; ++ai) {
#pragma unroll
            for (int m = 0; m < 4; ++m) rinvh[ai][m] = rsqrtf(sum8(ssqq + (size_t)(u.pm * 256 + ai * 128 + wr * 64 + fr + 16 * m + zdep) * 8) * (1.f / 384.f) + EPS) * qs;
            asm volatile("v_mov_b32 %0, 0" : "=v"(zdep) : "v"(rinvh[ai][0]), "v"(rinvh[ai][1]), "v"(rinvh[ai][2]), "v"(rinvh[ai][3]));
        }
#pragma unroll
        for (int ai = 0; ai < 2; ++ai) {
            const int rb = u.pm * 256 + ai * 128 + wr * 64 + fr;
            int mb, pos0, kv0; row_info(rb, mb, pos0, kv0);
#pragma unroll
            for (int m = 0; m < 4; ++m) {
                const int row = rb + 16 * m, pos = pos0 + 16 * m;
                const float rinv = rinvh[ai][m];
#pragma unroll
                for (int bj = 0; bj < 2; ++bj) {
                    float v[8];
#pragma unroll
                    for (int n = 0; n < 2; ++n)
#pragma unroll
                        for (int j = 0; j < 4; ++j) v[4 * n + j] = acc[ai][bj][m][n][j] * rinv;
                    if (u.pn < 2) {
                        *(u32x4*)(qn + (size_t)row * 512 + u.pn * 256 + bj * 128 + cl) = pack8(v);
                    } else {
                        const int head = 4 * bj + wc;
                        float o1[4], o2[4];
#pragma unroll
                        for (int j = 0; j < 4; ++j) { const int i = 4 * fq + j; float sn, cs; sincos_rev((float)pos * ex2(-(float)i * KEXP32), sn, cs);
                            o1[j] = v[j] * cs - v[4 + j] * sn; o2[j] = v[j] * sn + v[4 + j] * cs; }
                        *(u32x2*)(qr + (size_t)row * 256 + head * 32 + 4 * fq) = pack4(o1);
                        *(u32x2*)(qr + (size_t)row * 256 + head * 32 + 16 + 4 * fq) = pack4(o2);
                    }
                }
            }
        }
    }
};

struct EpiKV {
    int mode; unsigned char* ws;
    DI void operator()(AccRef acc, const Unit& u, int wr, int wc, int fr, int fq) const {
        const int cl = wc * 32 + fq * 8;
        const float* ssqkv = (const float*)(ws + WS_SSQKV); bf16_t *kn = (bf16_t*)(ws + WS_U + U_KN), *vm = (bf16_t*)(ws + WS_U + U_VM);
        bf16_t* dst = u.pn < 2 ? kn : vm;
        const int cb = (u.pn & 1) * 256;
        float rinvh[2][4];
#pragma unroll
        for (int ai = 0; ai < 2; ++ai)
#pragma unroll
            for (int m = 0; m < 4; ++m) rinvh[ai][m] = mode == 0 ? rsqrtf(sum4(ssqkv + (size_t)(u.pm * 256 + ai * 128 + wr * 64 + fr + 16 * m) * 4) * (1.f / 256.f) + EPS) : 1.f;
#pragma unroll
        for (int ai = 0; ai < 2; ++ai) {
            const int rb = u.pm * 256 + ai * 128 + wr * 64 + fr;
#pragma unroll
            for (int m = 0; m < 4; ++m) {
                const int row = rb + 16 * m;
                int kvrow; const float rinv = rinvh[ai][m];
                if (mode == 0) { int mb, pos; row_info(row, mb, pos, kvrow); }
                else { kvrow = MP + (row >> 10) * KVS + (row & 1023); }
#pragma unroll
                for (int bj = 0; bj < 2; ++bj) {
                    float v[8];
#pragma unroll
                    for (int n = 0; n < 2; ++n)
#pragma unroll
                        for (int j = 0; j < 4; ++j) v[4 * n + j] = acc[ai][bj][m][n][j] * rinv;
                    *(u32x4*)(dst + (size_t)kvrow * 512 + cb + bj * 128 + cl) = pack8(v);
                }
            }
        }
    }
};

struct EpiRes {
    const float* xin_p; const float* xin_s;
    float* xout; unsigned char* ws; int gate_off, scn_off, has_ap;
    const float* gn;
    DI void operator()(AccRef acc, const Unit& u, int wr, int wc, int fr, int fq) const {
        const int cl = wc * 32 + fq * 8;
        const float* gate = (const float*)(ws + WS_MOD) + gate_off; const float* scn = (const float*)(ws + WS_MOD) + scn_off;
        bf16_t* ap = has_ap ? (bf16_t*)(ws + WS_U + U_AP) : nullptr; float* ssq = (float*)(ws + WS_SSQ);
#pragma unroll
        for (int ai = 0; ai < 2; ++ai) {
            const int rb = u.pm * 256 + ai * 128 + wr * 64 + fr;
            int mb, pos0, kv0; row_info(rb, mb, pos0, kv0);
            f32x4 gt[2][2], gs[2][2];
#pragma unroll
            for (int bj = 0; bj < 2; ++bj)
#pragma unroll
                for (int n = 0; n < 2; ++n) {
                    const int c = u.pn * 256 + bj * 128 + cl + 4 * n;
                    gt[bj][n] = *(const f32x4*)(gate + (size_t)mb * 6144 + c);
                    if (ap) { const f32x4 g = *(const f32x4*)(gn + c), s = *(const f32x4*)(scn + (size_t)mb * 6144 + c); gs[bj][n] = g * (s + 1.f); }
                }
#pragma unroll
            for (int m = 0; m < 4; ++m) {
                const int row = rb + 16 * m;
                const float* xi = row < MP ? xin_p + (size_t)row * 1024 : xin_s + (size_t)(row - MP) * 1024;
                float s = 0.f;
#pragma unroll
                for (int bj = 0; bj < 2; ++bj) {
                    const int c = u.pn * 256 + bj * 128 + cl;
                    float v[8];
#pragma unroll
                    for (int n = 0; n < 2; ++n) {
                        const f32x4 x = *(const f32x4*)(xi + c + 4 * n);
                        const f32x4 y = x + gt[bj][n] * acc[ai][bj][m][n];
                        *(f32x4*)(xout + (size_t)row * 1024 + c + 4 * n) = y;
#pragma unroll
                        for (int j = 0; j < 4; ++j) { s += y[j] * y[j]; v[4 * n + j] = ap ? y[j] * gs[bj][n][j] : 0.f; }
                    }
                    if (ap) *(u32x4*)(ap + (size_t)row * 1024 + c) = pack8(v);
                }
                s = xor16_32(s);
                if (fq == 0) ssq[(size_t)row * 16 + u.pn * 4 + wc] = s;
            }
        }
    }
};

constexpr size_t U_HA = 0, U_HB = al(U_HA + (size_t)(MT / 64) * 2 * DFF * 4), U_TA = al(U_HB + (size_t)(MT / 64) * 2 * DFF * 4), U_SIDE_END = al(U_TA + (size_t)(MT / 64) * 2 * DFF * 4);
static_assert(U_SIDE_END <= U_B, "side buffers must not reach the gated buffer");
template <int CTRL> DI float dppf(float x) { return __builtin_bit_cast(float, __builtin_amdgcn_update_dpp(0, __builtin_bit_cast(int, x), CTRL, 0xf, 0xf, false)); }

DI f32x4 ldg4(const void* base, unsigned off) { return *(const GAS f32x4*)((const GAS char*)base + off); }
DI void stg4(void* base, unsigned off, f32x4 v) { *(GAS f32x4*)((GAS char*)base + off) = v; }
struct EpiUp {
    int l; unsigned char* ws; float* out; const float* convw; const float* convb; const float* sconv;
    DI void operator()(AccRef acc, const Unit& u, int wr, int wc, int fr, int fq) const {
        const int cl = wc * 32 + fq * 8;
        const unsigned clb = (unsigned)cl * 4u;
        const float* ssq = (const float*)(ws + WS_SSQ);
        bf16_t* b_ = (bf16_t*)(ws + WS_U + U_B);
        const int pnu = __builtin_amdgcn_readfirstlane(u.pn);
        const float* cwt = convw + (size_t)l * 3 * DFF + pnu * 128; const float* cbt = convb + (size_t)l * DFF + pnu * 128;
#pragma unroll
        for (int ai = 0; ai < 2; ++ai) {
            const int G64 = __builtin_amdgcn_readfirstlane(u.pm * 4 + ai * 2 + wr);
            const int rb0 = G64 * 64;
            const bool samp = rb0 >= MP;
            const int mb = samp ? 8 + ((rb0 - MP) >> 6) : (rb0 >> 11);
            const bool seqstart = samp || ((G64 & 31) == 0);
            const bool seqend = samp || ((G64 & 31) == 31);
            const float* cvt = (const float*)(ws + WS_CV2) + ((size_t)l * 24 + mb) * NUP + pnu * 256;
            const float* stt = sconv + ((size_t)(l * 16 + (samp ? G64 - MP / 64 : 0)) * 2) * DFF + pnu * 128;
            float* hat = (float*)(ws + WS_U + U_HA) + ((size_t)G64 * 2) * DFF + pnu * 128;
            float* hbt = (float*)(ws + WS_U + U_HB) + ((size_t)G64 * 2) * DFF + pnu * 128;
            float* tat = (float*)(ws + WS_U + U_TA) + ((size_t)G64 * 2) * DFF + pnu * 128;
            float* cot = (samp ? out + O_SCONV + ((size_t)(l * 16 + (G64 - MP / 64)) * 2) * DFF : out + O_PCONV + ((size_t)(l * 8 + (G64 >> 5)) * 2) * DFF) + pnu * 128;
            const unsigned rowb = (unsigned)(rb0 + fr);
            float rinv[4];
#pragma unroll
            for (int m = 0; m < 4; ++m) rinv[m] = rsqrtf(sum16((const float*)((const char*)ssq + (rowb + 16u * m) * 64u)) * (1.f / 1024.f) + EPS);
            const unsigned bo = (rowb * (unsigned)DFF + (unsigned)(pnu * 128 + cl)) * 2u;
#pragma unroll
            for (int n = 0; n < 2; ++n) {
                const unsigned co = clb + 16u * n;
                const f32x4 cva = ldg4(cvt, co), cvb = ldg4(cvt, co + 512u);
                const f32x4 w0 = ldg4(cwt, co), w1 = ldg4(cwt, co + (unsigned)DFF * 4u), w2 = ldg4(cwt, co + (unsigned)DFF * 8u), cb = ldg4(cbt, co);
                f32x4 h1 = (f32x4){0.f, 0.f, 0.f, 0.f}, h2 = h1;
                if (samp) { h2 = ldg4(stt, co); h1 = ldg4(stt, co + (unsigned)DFF * 4u); }
                f32x4 a[4];
#pragma unroll
                for (int m = 0; m < 4; ++m) a[m] = acc[ai][0][m][n] * rinv[m] + cva;
#pragma unroll
                for (int m = 0; m < 4; ++m) {
                    const f32x4 bv = acc[ai][1][m][n] * rinv[m] + cvb;
                    float gt[4];
#pragma unroll
                    for (int j = 0; j < 4; ++j) {
                        const float r1c = dppf<0x121>(a[m][j]), r2c = dppf<0x122>(a[m][j]);
                        float r1p, r2p;
                        if (m == 0) { r1p = h1[j]; r2p = fr == 0 ? h2[j] : h1[j]; }
                        else { r1p = dppf<0x121>(a[m - 1][j]); r2p = dppf<0x122>(a[m - 1][j]); }
                        const float p1 = fr == 0 ? r1p : r1c, p2 = fr < 2 ? r2p : r2c;
                        const float cvv = cb[j] + w0[j] * p2 + w1[j] * p1 + w2[j] * a[m][j];
                        gt[j] = silu(cvv) * bv[j];
                    }
                    if (m == 0 && fr < 2 && !seqstart) { stg4(hat, (unsigned)fr * (unsigned)DFF * 4u + co, a[0]); stg4(hbt, (unsigned)fr * (unsigned)DFF * 4u + co, bv); }
                    else *(u32x2*)((char*)b_ + bo + (unsigned)(16 * m) * (unsigned)DFF * 2u + 8u * n) = pack4(gt);
                }
                if (fr >= 14) {
                    stg4(tat, (unsigned)(fr - 14) * (unsigned)DFF * 4u + co, a[3]);
                    if (seqend) stg4(cot, (unsigned)(fr - 14) * (unsigned)DFF * 4u + co, a[3]);
                }
                asm volatile("" ::: "memory");
            }
        }
    }
};

DI void mla_item(int g_wave, LAS unsigned char* lds, const bf16_t* QN, const bf16_t* QR, const bf16_t* KN, const bf16_t* KRb, const bf16_t* VM, bf16_t* MIX,
                 int kvbase, int qrow0, int nq, int head, int ntiles, int wt) {
    const int tid = otid(), w = __builtin_amdgcn_readfirstlane(tid >> 6), lane = tid & 63, r = lane & 31, h = lane >> 5;
    constexpr int KST = 208, VST = 144, KB = 64 * KST, BUF = KB + 64 * VST;
    const bool active = 32 * w < nq;
    bf16x8 qf[6];
    {
        const int row = qrow0 + (active ? 32 * w + r : r);
#pragma unroll
        for (int s = 0; s < 4; ++s) qf[s] = *(const bf16x8*)(QN + (size_t)row * 512 + head * 64 + 16 * s + 8 * h);
#pragma unroll
        for (int s = 0; s < 2; ++s) qf[4 + s] = *(const bf16x8*)(QR + (size_t)row * 256 + head * 32 + 16 * s + 8 * h);
    }
    const int lk = tid >> 3, lc = tid & 7, rkk = (tid & 255) >> 2, rc = tid & 3;
    u32x4 gk, gv, gr;
#define MLA_LOAD(T) do { const size_t kr_ = (size_t)(kvbase + 64 * (T)); \
        gk = *(const u32x4*)(KN + (kr_ + lk) * 512 + head * 64 + lc * 8); gv = *(const u32x4*)(VM + (kr_ + lk) * 512 + head * 64 + lc * 8); \
        if (tid < 256) gr = *(const u32x4*)(KRb + (kr_ + rkk) * 32 + rc * 8); } while (0)
#define MLA_STORE(bi) do { LAS unsigned char* b_ = lds + (bi) * BUF; *(LAS u32x4*)(b_ + lk * KST + lc * 16) = gk; *(LAS u32x4*)(b_ + KB + lk * VST + lc * 16) = gv; \
        if (tid < 256) *(LAS u32x4*)(b_ + rkk * KST + 128 + rc * 16) = gr; } while (0)
    MLA_LOAD(0); MLA_STORE(0);
    __syncthreads();
    float m_run = -1e30f, l_run = 0.f;
    f32x16 o0, o1;
#pragma unroll
    for (int i = 0; i < 16; ++i) { o0[i] = 0.f; o1[i] = 0.f; }
    const int i16 = lane & 15, tq = i16 >> 2, tp = i16 & 3, blk = (lane >> 4) & 1;
    for (int T = 0; T < ntiles; ++T) {
        if (T + 1 < ntiles) MLA_LOAD(T + 1);
        if (T < wt) {
            LAS const unsigned char* base = lds + (T & 1) * BUF;
            f32x16 s0, s1;
#pragma unroll
            for (int i = 0; i < 16; ++i) { s0[i] = 0.f; s1[i] = 0.f; }
#pragma unroll
            for (int s = 0; s < 6; ++s) {
                const bf16x8 a0 = *(LAS const bf16x8*)(base + r * KST + (16 * s + 8 * h) * 2);
                const bf16x8 a1 = *(LAS const bf16x8*)(base + (32 + r) * KST + (16 * s + 8 * h) * 2);
                s0 = MFMA32(a0, qf[s], s0); s1 = MFMA32(a1, qf[s], s1);
            }
            float mx = s0[0];
#pragma unroll
            for (int i = 0; i < 16; ++i) { mx = fmaxf(mx, s0[i]); mx = fmaxf(mx, s1[i]); }
            mx = fmaxf(mx, shx(mx, lane, 32));
            const float m_new = fmaxf(m_run, mx), alpha = ex2(m_run - m_new);
            m_run = m_new;
            float ls = 0.f;
#pragma unroll
            for (int i = 0; i < 16; ++i) { s0[i] = ex2(s0[i] - m_new); s1[i] = ex2(s1[i] - m_new); ls += s0[i] + s1[i]; }
            l_run = l_run * alpha + ls;
#pragma unroll
            for (int i = 0; i < 16; ++i) { o0[i] *= alpha; o1[i] *= alpha; }
            LAS const unsigned char* vb = base + KB;
#pragma unroll
            for (int kt = 0; kt < 2; ++kt)
#pragma unroll
                for (int ss = 0; ss < 2; ++ss) {
                    const bf16x8 pb = packfrag(kt == 0 ? s0 : s1, ss);
                    LAS const unsigned char* vp = vb + (32 * kt + 16 * ss + 4 * h + tq) * VST + (16 * blk + 4 * tp) * 2;
                    const bf16x8 a0 = tr_frag(vp, 8 * VST), a1 = tr_frag(vp + 64, 8 * VST);
                    o0 = MFMA32(a0, pb, o0); o1 = MFMA32(a1, pb, o1);
                }
        }
        if (T + 1 < ntiles) MLA_STORE((T + 1) & 1);
        LBAR();
    }
#undef MLA_LOAD
#undef MLA_STORE
    if (active) {
        const float lt = l_run + shx(l_run, lane, 32), inv = 1.f / lt;
        bf16_t* orow_ = MIX + (size_t)(qrow0 + 32 * w + r) * 1024 + head * 64;
#pragma unroll
        for (int g = 0; g < 4; ++g) {
            float a[4], b[4];
#pragma unroll
            for (int j = 0; j < 4; ++j) { a[j] = o0[4 * g + j] * inv; b[j] = o1[4 * g + j] * inv; }
            *(u32x2*)(orow_ + 8 * g + 4 * h) = pack4(a);
            *(u32x2*)(orow_ + 32 + 8 * g + 4 * h) = pack4(b);
        }
    }
}

DI void sb_item(int g_wave, LAS unsigned char* lds, const bf16_t* SQ, const float* kf, const float* vf, bf16_t* MIX, int kvbase, int qrow0, int qpos0, int nq, int head,
                const float* ck, const float* cvp) {
    const int tid = otid(), w = __builtin_amdgcn_readfirstlane(tid >> 6), lane = tid & 63, r = lane & 31, h = lane >> 5;
    constexpr int ST = 144, KB = 64 * ST, BUF = 2 * KB;
    const bool active = 32 * w < nq;
    bf16x8 qf[4];
    {
        const int row = qrow0 + (active ? 32 * w + r : r);
#pragma unroll
        for (int s = 0; s < 4; ++s) qf[s] = *(const bf16x8*)(SQ + (size_t)row * 256 + head * 64 + 16 * s + 8 * h);
    }
    const int qp = qpos0 + 32 * w + r;
    const int wmax = active ? qpos0 + 32 * w + 30 : -1;
    const int Ttop = (qpos0 + nq - 2) >> 6;
    const int lk = tid >> 3, lc = tid & 7;
    u32x4 gk, gv;
#define SB_LOAD(T) do { const int tn_ = ck ? (T) - 16 : (T); const float* kp_ = (ck && (T) < 16) ? ck + (size_t)(64 * (T) + lk) * 256 : kf + (size_t)(64 * tn_ + lk) * 256; \
        const float* vp_ = (ck && (T) < 16) ? cvp + (size_t)(64 * (T) + lk) * 256 : vf + (size_t)(64 * tn_ + lk) * 256; const int o_ = head * 64 + lc * 8; \
        const f32x4 k0_ = *(const f32x4*)(kp_ + o_), k1_ = *(const f32x4*)(kp_ + o_ + 4), v0_ = *(const f32x4*)(vp_ + o_), v1_ = *(const f32x4*)(vp_ + o_ + 4); \
        gk.x = pk2(k0_[0], k0_[1]); gk.y = pk2(k0_[2], k0_[3]); gk.z = pk2(k1_[0], k1_[1]); gk.w = pk2(k1_[2], k1_[3]); gv.x = pk2(v0_[0], v0_[1]); gv.y = pk2(v0_[2], v0_[3]); gv.z = pk2(v1_[0], v1_[1]); gv.w = pk2(v1_[2], v1_[3]); } while (0)
#define SB_STORE(bi) do { LAS unsigned char* b_ = lds + (bi) * BUF; *(LAS u32x4*)(b_ + lk * ST + lc * 16) = gk; *(LAS u32x4*)(b_ + KB + lk * ST + lc * 16) = gv; } while (0)
    SB_LOAD(Ttop); SB_STORE(0);
    volatile LAS unsigned* fl = (volatile LAS unsigned*)(lds + LDS_MISC + 16);
    if (tid == 0) { fl[0] = 0u; fl[1] = 0u; fl[2] = 0u; }
    bool wdone = !active;
    __syncthreads();
    float A = 0.f;
    f32x16 o0, o1;
#pragma unroll
    for (int i = 0; i < 16; ++i) { o0[i] = 0.f; o1[i] = 0.f; }
    const int i16 = lane & 15, tq = i16 >> 2, tp = i16 & 3, blk = (lane >> 4) & 1;
    int it = 0;
    for (int T = Ttop; T >= 0; --T, ++it) {
        if (T > 0) SB_LOAD(T - 1);
        if (64 * T <= wmax && !wdone) {
            LAS const unsigned char* base = lds + (it & 1) * BUF;
            f32x16 z[2];
#pragma unroll
            for (int i = 0; i < 16; ++i) { z[0][i] = 0.f; z[1][i] = 0.f; }
#pragma unroll
            for (int s = 0; s < 4; ++s) {
                const bf16x8 a0 = *(LAS const bf16x8*)(base + r * ST + (16 * s + 8 * h) * 2);
                const bf16x8 a1 = *(LAS const bf16x8*)(base + (32 + r) * ST + (16 * s + 8 * h) * 2);
                z[0] = MFMA32(a0, qf[s], z[0]); z[1] = MFMA32(a1, qf[s], z[1]);
            }
            f32x16 L[2];
            float G[2][4], Go[2][4];
#pragma unroll
            for (int kt = 0; kt < 2; ++kt) {
#pragma unroll
                for (int i = 0; i < 16; ++i) {
                    const int key = 64 * T + 32 * kt + crow(i, h);
                    const float zz = z[kt][i];
                    const float e = ex2(-fabsf(zz) * LOG2E);
                    const float sp = fmaxf(zz, 0.f) + lg2(1.f + e) * LN2;
                    const bool valid = key < qp;
                    L[kt][i] = valid ? -sp : 0.f;
                    z[kt][i] = valid ? (zz - sp) : -1e30f;
                }
#pragma unroll
                for (int g = 0; g < 4; ++g) { G[kt][g] = (L[kt][4 * g] + L[kt][4 * g + 1]) + (L[kt][4 * g + 2] + L[kt][4 * g + 3]); Go[kt][g] = shx(G[kt][g], lane, 32); }
            }
            float run = A;
#pragma unroll
            for (int kt = 1; kt >= 0; --kt)
#pragma unroll
                for (int g = 3; g >= 0; --g) {
                    float af = run + (h == 0 ? Go[kt][g] : 0.f);
                    z[kt][4 * g + 3] = ex2((z[kt][4 * g + 3] + af) * LOG2E); af += L[kt][4 * g + 3];
                    z[kt][4 * g + 2] = ex2((z[kt][4 * g + 2] + af) * LOG2E); af += L[kt][4 * g + 2];
                    z[kt][4 * g + 1] = ex2((z[kt][4 * g + 1] + af) * LOG2E); af += L[kt][4 * g + 1];
                    z[kt][4 * g + 0] = ex2((z[kt][4 * g + 0] + af) * LOG2E);
                    run += (h == 0 ? G[kt][g] + Go[kt][g] : Go[kt][g] + G[kt][g]);
                }
            A = run;
            wdone = __builtin_amdgcn_ballot_w64(A < -150.f) == ~0ull;
            LAS const unsigned char* vb = base + KB;
#pragma unroll
            for (int kt = 0; kt < 2; ++kt)
#pragma unroll
                for (int ss = 0; ss < 2; ++ss) {
                    const bf16x8 pb = packfrag(z[kt], ss);
                    LAS const unsigned char* vp = vb + (32 * kt + 16 * ss + 4 * h + tq) * ST + (16 * blk + 4 * tp) * 2;
                    const bf16x8 a0 = tr_frag(vp, 8 * ST), a1 = tr_frag(vp + 64, 8 * ST);
                    o0 = MFMA32(a0, pb, o0); o1 = MFMA32(a1, pb, o1);
                }
        }
        if (T > 0) SB_STORE((it + 1) & 1);
        const int fw = it % 3;
        if (lane == 0 && !wdone) fl[fw] = 1u;
        LBAR();
        const unsigned alive = fl[fw];
        if (tid == 0) fl[(it + 2) % 3] = 0u;
        if (!alive) break;
    }
#undef SB_LOAD
#undef SB_STORE
    if (active) {
        bf16_t* orow_ = MIX + (size_t)(qrow0 + 32 * w + r) * 1024 + 768 + head * 64;
#pragma unroll
        for (int g = 0; g < 4; ++g) {
            float a[4], b[4];
#pragma unroll
            for (int j = 0; j < 4; ++j) { a[j] = o0[4 * g + j]; b[j] = o1[4 * g + j]; }
            *(u32x2*)(orow_ + 8 * g + 4 * h) = pack4(a);
            *(u32x2*)(orow_ + 32 + 8 * g + 4 * h) = pack4(b);
        }
    }
}

DI void uc_item(int g_wave, LAS unsigned char* lds, const bf16_t* RK, const bf16_t* RV, float* dst, int row0, int head) {
    const int tid = otid(), w = __builtin_amdgcn_readfirstlane(tid >> 6), lane = tid & 63, h = lane >> 5;
    constexpr int ST = 144, TB = 64 * ST;
    const float lgam = lg2(1.f - ex2(-5.f - (float)head));
    const int lk = tid >> 3, lc = tid & 7;
    const float kdec = ex2(lgam * (float)(63 - lk));
    {
        const size_t rr_ = (size_t)(row0 + lk) * 256 + head * 64 + lc * 8;
        const u32x4 gk = *(const u32x4*)(RK + rr_), gv = *(const u32x4*)(RV + rr_);
        u32x4 kd_; kd_.x = pk2(bflo(gk.x) * kdec, bfhi(gk.x) * kdec); kd_.y = pk2(bflo(gk.y) * kdec, bfhi(gk.y) * kdec); kd_.z = pk2(bflo(gk.z) * kdec, bfhi(gk.z) * kdec); kd_.w = pk2(bflo(gk.w) * kdec, bfhi(gk.w) * kdec);
        *(LAS u32x4*)(lds + lk * ST + lc * 16) = kd_; *(LAS u32x4*)(lds + TB + lk * ST + lc * 16) = gv;
    }
    __syncthreads();
    if (w < 4) {
        const int et = w >> 1, dt = w & 1;
        const int i16 = lane & 15, tq = i16 >> 2, tp = i16 & 3, blk = (lane >> 4) & 1;
        f32x16 sacc;
#pragma unroll
        for (int i = 0; i < 16; ++i) sacc[i] = 0.f;
#pragma unroll
        for (int ks = 0; ks < 4; ++ks) {
            LAS const unsigned char* vp = lds + TB + (16 * ks + 4 * h + tq) * ST + (32 * et + 16 * blk + 4 * tp) * 2;
            LAS const unsigned char* kp = lds + (16 * ks + 4 * h + tq) * ST + (32 * dt + 16 * blk + 4 * tp) * 2;
            const bf16x8 a = tr_frag(vp, 8 * ST), b = tr_frag(kp, 8 * ST);
            sacc = MFMA32(a, b, sacc);
        }
#pragma unroll
        for (int g = 0; g < 4; ++g) *(f32x4*)(dst + ((w * 4 + g) * 64 + lane) * 4) = (f32x4){sacc[4 * g], sacc[4 * g + 1], sacc[4 * g + 2], sacc[4 * g + 3]};
    }
    __syncthreads();
}

DI void ret_item(int g_wave, LAS unsigned char* lds, const bf16_t* RQ, const bf16_t* RK, const bf16_t* RV, const bf16_t* RG, const float* gret, bf16_t* MIX,
                 int row0, int nchunks, int head, const float* S0, float* Sout, const float* UCb, int c0) {
    const int tid = otid(), w = __builtin_amdgcn_readfirstlane(tid >> 6), lane = tid & 63, r = lane & 31, h = lane >> 5;
    constexpr int ST = 144, TB = 64 * ST, DBUF = 5 * TB, SOFF = 2 * DBUF;
    const float lgam = lg2(1.f - ex2(-5.f - (float)head));
    const float g64 = ex2(lgam * 64.f);
    const int lk = tid >> 3, lc = tid & 7;
    const float kdec = ex2(lgam * (float)(63 - lk));
    u32x4 aq, ak, av, ag, bq, bk, bv, bg;
#define RT_LOADX(c, gq, gk, gv, gg) do { const size_t rr_ = (size_t)(row0 + 64 * (c) + lk) * 256 + head * 64 + lc * 8; gq = *(const u32x4*)(RQ + rr_); gk = *(const u32x4*)(RK + rr_); gv = *(const u32x4*)(RV + rr_); gg = *(const u32x4*)(RG + rr_); } while (0)
#define RT_STOREX(bi, gq, gk, gv, gg) do { LAS unsigned char* b_ = lds + (bi) * DBUF + lk * ST + lc * 16; *(LAS u32x4*)(b_) = gq; *(LAS u32x4*)(b_ + TB) = gk; \
        u32x4 kd_; kd_.x = pk2(bflo(gk.x) * kdec, bfhi(gk.x) * kdec); kd_.y = pk2(bflo(gk.y) * kdec, bfhi(gk.y) * kdec); kd_.z = pk2(bflo(gk.z) * kdec, bfhi(gk.z) * kdec); kd_.w = pk2(bflo(gk.w) * kdec, bfhi(gk.w) * kdec); \
        *(LAS u32x4*)(b_ + 2 * TB) = kd_; *(LAS u32x4*)(b_ + 3 * TB) = gv; *(LAS u32x4*)(b_ + 4 * TB) = gg; } while (0)
    RT_LOADX(0, aq, ak, av, ag); RT_STOREX(0, aq, ak, av, ag);
    if (nchunks > 1) RT_LOADX(1, aq, ak, av, ag);
    if (tid < 16) *(LAS f32x4*)(lds + SOFF + 2 * TB + tid * 16) = *(const f32x4*)(gret + head * 64 + tid * 4);
    const int et = (w - 2) >> 1, dt = (w - 2) & 1;
    f32x16 sacc;
#pragma unroll
    for (int i = 0; i < 16; ++i) sacc[i] = 0.f;
    if (w >= 2 && w < 6) {
        LAS unsigned char* st1 = lds + SOFF + TB;
#pragma unroll
        for (int g = 0; g < 4; ++g) {
            f32x4 v = (f32x4){0.f, 0.f, 0.f, 0.f};
            if (S0) v = *(const f32x4*)(S0 + (size_t)(32 * dt + r) * 64 + 32 * et + 8 * g + 4 * h);
            if (UCb) {
                for (int j = 0; j < c0; ++j) { const f32x4 u = *(const f32x4*)(UCb + (size_t)j * 4096 + (((w - 2) * 4 + g) * 64 + lane) * 4); v = v * g64 + u; }
            }
#pragma unroll
            for (int j = 0; j < 4; ++j) { sacc[4 * g + j] = v[j]; *(LAS bf16_t*)(st1 + (32 * et + 8 * g + 4 * h + j) * ST + (32 * dt + r) * 2) = (bf16_t)(pk2(v[j], 0.f) & 0xffffu); }
        }
    }
    const int lq = 32 * (w & 1) + r;
    const float gl = ex2(lgam * (float)lq), qd = ex2(lgam * (float)(lq + 1));
    float gm[2][16];
#pragma unroll
    for (int mt = 0; mt < 2; ++mt)
#pragma unroll
        for (int i = 0; i < 16; ++i) { const int mm = 32 * mt + crow(i, h); gm[mt][i] = (lq >= mm) ? gl * ex2(-lgam * (float)mm) : 0.f; }
    __syncthreads();
    const int i16 = lane & 15, tq = i16 >> 2, tp = i16 & 3, blk = (lane >> 4) & 1;
    for (int c0 = 0; c0 < nchunks; c0 += 2) {
        {
        const int c = c0;
        if (c + 2 < nchunks) RT_LOADX(c + 2, bq, bk, bv, bg);
        LAS const unsigned char* base = lds + (c & 1) * DBUF;
        LAS const unsigned char* stp = lds + SOFF + ((c + 1) & 1) * TB;
        LAS unsigned char* stn = lds + SOFF + (c & 1) * TB;
        if (w < 2 || w >= 6) {
            const int oe = w >= 6 ? 1 : 0;
            bf16x8 qf[4];
#pragma unroll
            for (int s = 0; s < 4; ++s) qf[s] = *(LAS const bf16x8*)(base + lq * ST + (16 * s + 8 * h) * 2);
            f32x16 at[2];
#pragma unroll
            for (int i = 0; i < 16; ++i) { at[0][i] = 0.f; at[1][i] = 0.f; }
#pragma unroll
            for (int s = 0; s < 4; ++s) {
                const bf16x8 a0 = *(LAS const bf16x8*)(base + TB + r * ST + (16 * s + 8 * h) * 2);
                const bf16x8 a1 = *(LAS const bf16x8*)(base + TB + (32 + r) * ST + (16 * s + 8 * h) * 2);
                at[0] = MFMA32(a0, qf[s], at[0]); at[1] = MFMA32(a1, qf[s], at[1]);
            }
#pragma unroll
            for (int mt = 0; mt < 2; ++mt)
#pragma unroll
                for (int i = 0; i < 16; ++i) at[mt][i] *= gm[mt][i];
            f32x16 pv, sq_;
#pragma unroll
            for (int i = 0; i < 16; ++i) { pv[i] = 0.f; sq_[i] = 0.f; }
#pragma unroll
            for (int mt = 0; mt < 2; ++mt)
#pragma unroll
                for (int ss = 0; ss < 2; ++ss) {
                    const bf16x8 pb = packfrag(at[mt], ss);
                    LAS const unsigned char* vp = base + 3 * TB + (32 * mt + 16 * ss + 4 * h + tq) * ST + (32 * oe + 16 * blk + 4 * tp) * 2;
                    pv = MFMA32(tr_frag(vp, 8 * ST), pb, pv);
                }
#pragma unroll
            for (int s = 0; s < 4; ++s) {
                const bf16x8 a0 = *(LAS const bf16x8*)(stp + (32 * oe + r) * ST + (16 * s + 8 * h) * 2);
                sq_ = MFMA32(a0, qf[s], sq_);
            }
            float s1 = 0.f, s2 = 0.f;
#pragma unroll
            for (int i = 0; i < 16; ++i) { pv[i] += qd * sq_[i]; s1 += pv[i]; s2 += pv[i] * pv[i]; }
            s1 += shx(s1, lane, 32); s2 += shx(s2, lane, 32);
            LAS f32x2* xs = (LAS f32x2*)(lds + SOFF + 2 * TB + 256);
            if (h == 0) xs[oe * 64 + lq] = (f32x2){s1, s2};
            LBAR();
            const f32x2 po = xs[(oe ^ 1) * 64 + lq];
            const float t1 = oe ? po[0] + s1 : s1 + po[0], t2 = oe ? po[1] + s2 : s2 + po[1];
            const float mu = t1 * (1.f / 64.f);
            const float rs = rsqrtf(fmaxf(t2 * (1.f / 64.f) - mu * mu, 0.f) + EPS);
            const size_t row = (size_t)(row0 + 64 * c + lq);
#pragma unroll
            for (int g = 0; g < 4; ++g) {
                const int el = 32 * oe + 8 * g + 4 * h, ec = head * 64 + el;
                const u32x2 gg = *(LAS const u32x2*)(base + 4 * TB + lq * ST + el * 2);
                const f32x4 gr = *(LAS const f32x4*)(lds + SOFF + 2 * TB + el * 4);
                float o[4];
                o[0] = (pv[4 * g + 0] - mu) * rs * gr[0] * bflo(gg.x); o[1] = (pv[4 * g + 1] - mu) * rs * gr[1] * bfhi(gg.x);
                o[2] = (pv[4 * g + 2] - mu) * rs * gr[2] * bflo(gg.y); o[3] = (pv[4 * g + 3] - mu) * rs * gr[3] * bfhi(gg.y);
                *(u32x2*)(MIX + row * 1024 + 512 + ec) = pack4(o);
            }
        } else if (w < 6) {
#pragma unroll
            for (int i = 0; i < 16; ++i) sacc[i] *= g64;
#pragma unroll
            for (int ks = 0; ks < 4; ++ks) {
                LAS const unsigned char* vp = base + 3 * TB + (16 * ks + 4 * h + tq) * ST + (32 * et + 16 * blk + 4 * tp) * 2;
                LAS const unsigned char* kp = base + 2 * TB + (16 * ks + 4 * h + tq) * ST + (32 * dt + 16 * blk + 4 * tp) * 2;
                const bf16x8 a = tr_frag(vp, 8 * ST), b = tr_frag(kp, 8 * ST);
                sacc = MFMA32(a, b, sacc);
            }
#pragma unroll
            for (int i = 0; i < 16; ++i) *(LAS bf16_t*)(stn + (32 * et + crow(i, h)) * ST + (32 * dt + r) * 2) = (bf16_t)(pk2(sacc[i], 0.f) & 0xffffu);
            LBAR();
        }
        if (c + 1 < nchunks) RT_STOREX((c + 1) & 1, aq, ak, av, ag);
        LBAR();
            }
        if (c0 + 1 >= nchunks) break;
        {
        const int c = c0 + 1;
        if (c + 2 < nchunks) RT_LOADX(c + 2, aq, ak, av, ag);
        LAS const unsigned char* base = lds + (c & 1) * DBUF;
        LAS const unsigned char* stp = lds + SOFF + ((c + 1) & 1) * TB;
        LAS unsigned char* stn = lds + SOFF + (c & 1) * TB;
        if (w < 2 || w >= 6) {
            const int oe = w >= 6 ? 1 : 0;
            bf16x8 qf[4];
#pragma unroll
            for (int s = 0; s < 4; ++s) qf[s] = *(LAS const bf16x8*)(base + lq * ST + (16 * s + 8 * h) * 2);
            f32x16 at[2];
#pragma unroll
            for (int i = 0; i < 16; ++i) { at[0][i] = 0.f; at[1][i] = 0.f; }
#pragma unroll
            for (int s = 0; s < 4; ++s) {
                const bf16x8 a0 = *(LAS const bf16x8*)(base + TB + r * ST + (16 * s + 8 * h) * 2);
                const bf16x8 a1 = *(LAS const bf16x8*)(base + TB + (32 + r) * ST + (16 * s + 8 * h) * 2);
                at[0] = MFMA32(a0, qf[s], at[0]); at[1] = MFMA32(a1, qf[s], at[1]);
            }
#pragma unroll
            for (int mt = 0; mt < 2; ++mt)
#pragma unroll
                for (int i = 0; i < 16; ++i) at[mt][i] *= gm[mt][i];
            f32x16 pv, sq_;
#pragma unroll
            for (int i = 0; i < 16; ++i) { pv[i] = 0.f; sq_[i] = 0.f; }
#pragma unroll
            for (int mt = 0; mt < 2; ++mt)
#pragma unroll
                for (int ss = 0; ss < 2; ++ss) {
                    const bf16x8 pb = packfrag(at[mt], ss);
                    LAS const unsigned char* vp = base + 3 * TB + (32 * mt + 16 * ss + 4 * h + tq) * ST + (32 * oe + 16 * blk + 4 * tp) * 2;
                    pv = MFMA32(tr_frag(vp, 8 * ST), pb, pv);
                }
#pragma unroll
            for (int s = 0; s < 4; ++s) {
                const bf16x8 a0 = *(LAS const bf16x8*)(stp + (32 * oe + r) * ST + (16 * s + 8 * h) * 2);
                sq_ = MFMA32(a0, qf[s], sq_);
            }
            float s1 = 0.f, s2 = 0.f;
#pragma unroll
            for (int i = 0; i < 16; ++i) { pv[i] += qd * sq_[i]; s1 += pv[i]; s2 += pv[i] * pv[i]; }
            s1 += shx(s1, lane, 32); s2 += shx(s2, lane, 32);
            LAS f32x2* xs = (LAS f32x2*)(lds + SOFF + 2 * TB + 256);
            if (h == 0) xs[oe * 64 + lq] = (f32x2){s1, s2};
            LBAR();
            const f32x2 po = xs[(oe ^ 1) * 64 + lq];
            const float t1 = oe ? po[0] + s1 : s1 + po[0], t2 = oe ? po[1] + s2 : s2 + po[1];
            const float mu = t1 * (1.f / 64.f);
            const float rs = rsqrtf(fmaxf(t2 * (1.f / 64.f) - mu * mu, 0.f) + EPS);
            const size_t row = (size_t)(row0 + 64 * c + lq);
#pragma unroll
            for (int g = 0; g < 4; ++g) {
                const int el = 32 * oe + 8 * g + 4 * h, ec = head * 64 + el;
                const u32x2 gg = *(LAS const u32x2*)(base + 4 * TB + lq * ST + el * 2);
                const f32x4 gr = *(LAS const f32x4*)(lds + SOFF + 2 * TB + el * 4);
                float o[4];
                o[0] = (pv[4 * g + 0] - mu) * rs * gr[0] * bflo(gg.x); o[1] = (pv[4 * g + 1] - mu) * rs * gr[1] * bfhi(gg.x);
                o[2] = (pv[4 * g + 2] - mu) * rs * gr[2] * bflo(gg.y); o[3] = (pv[4 * g + 3] - mu) * rs * gr[3] * bfhi(gg.y);
                *(u32x2*)(MIX + row * 1024 + 512 + ec) = pack4(o);
            }
        } else if (w < 6) {
#pragma unroll
            for (int i = 0; i < 16; ++i) sacc[i] *= g64;
#pragma unroll
            for (int ks = 0; ks < 4; ++ks) {
                LAS const unsigned char* vp = base + 3 * TB + (16 * ks + 4 * h + tq) * ST + (32 * et + 16 * blk + 4 * tp) * 2;
                LAS const unsigned char* kp = base + 2 * TB + (16 * ks + 4 * h + tq) * ST + (32 * dt + 16 * blk + 4 * tp) * 2;
                const bf16x8 a = tr_frag(vp, 8 * ST), b = tr_frag(kp, 8 * ST);
                sacc = MFMA32(a, b, sacc);
            }
#pragma unroll
            for (int i = 0; i < 16; ++i) *(LAS bf16_t*)(stn + (32 * et + crow(i, h)) * ST + (32 * dt + r) * 2) = (bf16_t)(pk2(sacc[i], 0.f) & 0xffffu);
            LBAR();
        }
        if (c + 1 < nchunks) RT_STOREX((c + 1) & 1, bq, bk, bv, bg);
        LBAR();
            }
    }
#undef RT_LOADX
#undef RT_STOREX
    if (Sout && w >= 2 && w < 6) {
#pragma unroll
        for (int g = 0; g < 4; ++g)
            *(f32x4*)(Sout + (size_t)(32 * dt + r) * 64 + 32 * et + 8 * g + 4 * h) = (f32x4){sacc[4 * g], sacc[4 * g + 1], sacc[4 * g + 2], sacc[4 * g + 3]};
    }
}


#define XB_TMO      128
#define XB_XCNT(j)  (256  + 64 * (j))
#define XB_XSUB(j)  (1280 + 64 * (j))
#define XB_XGEN(j)  (2304 + 64 * (j))
#define XB_TOP      3328
#define XB_TOPGEN   3392
#define XCD_BAR_WORDS 3456
#define XB_SPIN_CAP (1u << 20)
DI unsigned xb_ld(unsigned* p)              { return __hip_atomic_load(p, __ATOMIC_RELAXED, __HIP_MEMORY_SCOPE_AGENT); }
DI unsigned xb_add(unsigned* p, unsigned v) { return __hip_atomic_fetch_add(p, v, __ATOMIC_RELAXED, __HIP_MEMORY_SCOPE_AGENT); }
DI unsigned xb_xcc_id() { return (unsigned)__builtin_amdgcn_s_getreg((3 << 11) | 20) & 0xFu; }
#define XB_SPIN(cond, bar) do { unsigned _sp = 0; while (cond) { __builtin_amdgcn_s_sleep(1); \
    if ((++_sp & 255u) == 0u) { if (xb_ld(&(bar)[XB_TMO])) break; if (_sp > XB_SPIN_CAP) { atomicAdd(&(bar)[XB_TMO], 1u); break; } } } } while (0)
DI void xcd_barrier_complete(unsigned* bar, unsigned x, unsigned& nloc, unsigned& nx) {
    const unsigned G = gridDim.x * gridDim.y * gridDim.z;
    unsigned sum, cnt, mine, sp = 0u;
    for (;;) {
        sum = 0u; cnt = 0u; mine = 0u;
#pragma unroll
        for (unsigned j = 0; j < 16; ++j) { const unsigned c = xb_ld(&bar[XB_XCNT(j)]); sum += c; cnt += (c > 0u) ? 1u : 0u; mine = (j == x) ? c : mine; }
        if (sum == G) break;
        __builtin_amdgcn_s_sleep(1);
        if ((++sp & 255u) == 0u) { if (xb_ld(&bar[XB_TMO])) break; if (sp > XB_SPIN_CAP) { atomicAdd(&bar[XB_TMO], 1u); break; } }
    }
    nloc = mine > 0u ? mine : 1u; nx = cnt > 0u ? cnt : 1u;
}
DI void xcd_barrier(unsigned* bar, volatile LAS unsigned* st, bool leader) {
    asm volatile("s_waitcnt vmcnt(0)" ::: "memory");
    __syncthreads();
    if (leader) {
        const unsigned x = xb_xcc_id();
        __builtin_amdgcn_s_waitcnt(0);
        unsigned nloc = st[0], nx = st[1];
        if (nloc == 0u) { xcd_barrier_complete(bar, x, nloc, nx); st[0] = nloc; st[1] = nx; }
        const unsigned old = xb_add(&bar[XB_XSUB(x)], 1u);
        const unsigned gen = old / nloc;
        if (old + 1u == (gen + 1u) * nloc) {
            __builtin_amdgcn_fence(__ATOMIC_RELEASE, "agent");
            asm volatile("s_waitcnt vmcnt(0)" ::: "memory");
            const unsigned og = xb_add(&bar[XB_TOP], 1u);
            const unsigned tg = og / nx;
            if (og + 1u == (tg + 1u) * nx) xb_add(&bar[XB_TOPGEN], 1u);
            else XB_SPIN(xb_ld(&bar[XB_TOPGEN]) == tg, bar);
            __builtin_amdgcn_fence(__ATOMIC_ACQUIRE, "agent");
            xb_add(&bar[XB_XGEN(x)], 1u);
            asm volatile("s_waitcnt vmcnt(0)" ::: "memory");
        } else {
            XB_SPIN(xb_ld(&bar[XB_XGEN(x)]) == gen, bar);
            __builtin_amdgcn_fence(__ATOMIC_ACQUIRE, "agent");
            asm volatile("s_waitcnt vmcnt(0)" ::: "memory");
        }
    }
    __syncthreads();
}

DI int colmap(int job, int n) {
    switch (job) {
        case 0: {
            const int T = n >> 8, c = n & 255;
            if (T == 0) return 384 + c;
            if (T == 1) return c;
            if (T == 2) { if (c < 128) return 256 + c; if (c < 160) { const int p = c - 128; return 640 + 4 * (p >> 3) + (p & 3) + 16 * ((p >> 2) & 1); } return -1; }
            if (T == 3 || T == 4) { const int hh = c >> 6, p = c & 63; return (T == 3 ? 672 : 928) + 64 * hh + 4 * (p >> 3) + (p & 3) + 32 * ((p >> 2) & 1); }
            return 1184 + (T - 5) * 256 + c;
        }
        case 1: {
            if (n < 512) return (n >> 6) * 96 + (n & 63);
            const int q = n - 512, hh = q >> 5, p = q & 31; return hh * 96 + 64 + 4 * (p >> 3) + (p & 3) + 16 * ((p >> 2) & 1);
        }
        case 2: case 3: return n < 512 ? (n >> 6) * 128 + (n & 63) : ((n - 512) >> 6) * 128 + 64 + (n & 63);
        case 5: { const int j = n >> 8, c = n & 255; return c < 128 ? 128 * j + c : DFF + 128 * j + (c - 128); }
        default: return n;
    }
}
DI void transpose_item(int g_wave, LAS unsigned char* lds, const float* src, int K, int Nsrc, bf16_t* dst, int job, const float* rscale, int kt, int ntile) {
    LAS float* t = (LAS float*)lds;
    const int tid = otid();
    {
        const int nl = tid & 255, k0 = tid >> 8;
        const int ns = colmap(job, ntile * 256 + nl);
        float v[32];
#pragma unroll
        for (int kk = 0; kk < 32; ++kk) { const int k = kt * 64 + k0 + 2 * kk; v[kk] = ns >= 0 ? src[(size_t)k * Nsrc + ns] : 0.f; }
        if (rscale) {
#pragma unroll
            for (int kk = 0; kk < 32; ++kk) v[kk] *= rscale[kt * 64 + k0 + 2 * kk];
        }
#pragma unroll
        for (int kk = 0; kk < 32; ++kk) t[(k0 + 2 * kk) * 257 + nl] = v[kk];
    }
    __syncthreads();
#pragma unroll
    for (int q = 0; q < 4; ++q) {
        const int idx = tid + 512 * q, nl = idx >> 3, ks = idx & 7;
        float v[8];
#pragma unroll
        for (int j = 0; j < 8; ++j) v[j] = t[(ks * 8 + j) * 257 + nl];
        *(u32x4*)(dst + (size_t)(ntile * 256 + nl) * K + kt * 64 + ks * 8) = pack8(v);
    }
    __syncthreads();
}

#ifndef REP_SYNC
#define REP_SYNC 1
#endif
#define GSYNC() do { for (int r_ = 0; r_ < REP_SYNC; ++r_) { const int t_ = otid(); xcd_barrier((unsigned*)(osp(P.ws) + WS_CTL), (volatile LAS unsigned*)(lds + LDS_MISC + 8), t_ == 0); } } while (0)
#define PIN(i) gptr(P.in[i])
#define PH_BEGIN const int tid = otid(); const int G = gridDim.x; const int bid = osi((int)blockIdx.x); unsigned char* ws = osp(P.ws); float* out = osp(P.out); unsigned char* U = ws + WS_U; (void)tid; (void)G; (void)bid; (void)out; (void)U;
#define WSP(T, off) ((T*)(ws + (off)))
#define UP(off) ((bf16_t*)(U + (off)))

#define TRANSPOSE_DISPATCH(l_, q_) do { const int l = (l_), q = (q_); \
            int j, qi, K, Ns; size_t off; const float* srcb; \
            if (q < 160) { j = 0; qi = q; K = 1024; Ns = 2464; srcb = PIN(I_WIN); off = W_IN; } \
            else if (q < 178) { j = 1; qi = q - 160; K = 384; Ns = 768; srcb = PIN(I_WUQ); off = W_UQ; } \
            else if (q < 194) { j = 2; qi = q - 178; K = 256; Ns = 1024; srcb = PIN(I_WUKV); off = W_UKVG; } \
            else if (q < 210) { j = 3; qi = q - 194; K = 256; Ns = 1024; srcb = PIN(I_WUKV); off = W_UKV; } \
            else if (q < 274) { j = 4; qi = q - 210; K = 1024; Ns = 1024; srcb = PIN(I_WO); off = W_O; } \
            else if (q < 626) { j = 5; qi = q - 274; K = 1024; Ns = NUP; srcb = PIN(I_WUP); off = W_UP; } \
            else { j = 6; qi = q - 626; K = DFF; Ns = 1024; srcb = PIN(I_WDN); off = W_DN; } \
            const int nkt = K / 64, kt = qi % nkt, ntile = qi / nkt; \
            const float* src = srcb + (size_t)l * K * Ns; \
            const float* rs = j == 1 ? PIN(I_GQ) + l * 384 : (j == 2 ? PIN(I_GKV) + l * 256 : nullptr); \
            transpose_item(g_wave, lds, src, K, Ns, (bf16_t*)(ws + WS_W + l * W_LAYER + off), j, rs, kt, ntile); } while (0)

__global__ void __launch_bounds__(512, 2) mega(Params P) {
    extern __shared__ __attribute__((aligned(16))) unsigned char lds_raw[];
    LAS unsigned char* lds = (LAS unsigned char*)lds_raw;
    cg::grid_group grid = cg::this_grid();
    const int g_wave = __builtin_amdgcn_readfirstlane((int)threadIdx.x >> 6);
    if (threadIdx.x == 0) { *(volatile LAS unsigned*)(lds + LDS_MISC + 8) = 0u; *(volatile LAS unsigned*)(lds + LDS_MISC + 12) = 0u; (void)xb_add((unsigned*)(gptr(P.ws) + WS_CTL) + XB_XCNT(xb_xcc_id()), 1u); }
    __syncthreads();
    grid.sync();

#ifndef REP_P0
#define REP_P0 1
#endif
    for (int rep0 = 0; rep0 < REP_P0; ++rep0) {
        PH_BEGIN
        float* MOD = WSP(float, WS_MOD);
        for (int it = bid; it < 192; it += G) {
            const int l = it / 96, cb = it % 96;
            LAS float* sc = (LAS float*)lds;
            for (int idx = tid; idx < 24 * 1024; idx += 512) { const int b = idx >> 10, k = idx & 1023; const float c = b < 8 ? PIN(I_CP)[b * 1024 + k] : PIN(I_CS)[(b - 8) * 1024 + k]; sc[idx] = silu(c); }
            __syncthreads();
            const int cl0 = tid & 63, ks = tid >> 6;
            float acc[24];
#pragma unroll
            for (int b = 0; b < 24; ++b) acc[b] = 0.f;
            const float* wp = PIN(I_WADA) + (size_t)l * 1024 * 6144 + cb * 64 + cl0;
#pragma unroll 4
            for (int k4 = ks * 128; k4 < ks * 128 + 128; k4 += 4) {
                const float w0 = wp[(size_t)k4 * 6144], w1 = wp[(size_t)(k4 + 1) * 6144], w2 = wp[(size_t)(k4 + 2) * 6144], w3 = wp[(size_t)(k4 + 3) * 6144];
#pragma unroll
                for (int b = 0; b < 24; ++b) { const f32x4 sv = *(LAS const f32x4*)(sc + b * 1024 + k4); acc[b] += (sv[0] * w0 + sv[1] * w1) + (sv[2] * w2 + sv[3] * w3); }
            }
            __syncthreads();
#pragma unroll
            for (int b = 0; b < 24; ++b) sc[(ks * 24 + b) * 64 + cl0] = acc[b];
            __syncthreads();
            for (int idx = tid; idx < 24 * 64; idx += 512) {
                const int b = idx >> 6, cl = idx & 63;
                float sm = 0.f;
#pragma unroll
                for (int q = 0; q < 8; ++q) sm += sc[(q * 24 + b) * 64 + cl];
                const float mv = sm + PIN(I_BADA)[(size_t)l * 6144 + cb * 64 + cl];
                MOD[((size_t)l * 24 + b) * 6144 + cb * 64 + cl] = mv;
                const int col = cb * 64 + cl;
                if (col < 1024) WSP(bf16_t, WS_SHM)[(size_t)(32 * (2 * l) + b) * 1024 + col] = (bf16_t)(pk2(mv, 0.f) & 0xffffu);
                else if (col >= 3072 && col < 4096) WSP(bf16_t, WS_SHM)[(size_t)(32 * (2 * l + 1) + b) * 1024 + (col - 3072)] = (bf16_t)(pk2(mv, 0.f) & 0xffffu);
            }
            __syncthreads();
        }
        constexpr int per_layer = 160 + 18 + 16 + 16 + 64 + 352 + 176;
        for (int it = (bid + G - 192 % G) % G; it < per_layer; it += G) TRANSPOSE_DISPATCH(0, it);
        {
            bf16_t* CLB = WSP(bf16_t, WS_CLB);
            const size_t n8 = (size_t)2 * 16384 * 256 / 8;
            const float* src = PIN(I_CLAT);
#pragma unroll 4
            for (size_t i = (size_t)bid * 512 + tid; i < n8; i += (size_t)G * 512) {
                const f32x4 a = *(const f32x4*)(src + i * 8), b = *(const f32x4*)(src + i * 8 + 4);
                u32x4 w; w.x = pk2(a[0], a[1]); w.y = pk2(a[2], a[3]); w.z = pk2(b[0], b[1]); w.w = pk2(b[2], b[3]);
                *(u32x4*)(CLB + i * 8) = w;
            }
        }
    }
    GSYNC();
    for (int q = 0; q < 2; ++q) {
        PH_BEGIN
        const int l = q >> 1, up = q & 1;
        EpiC e; e.dst = up ? WSP(float, WS_CV2) + (size_t)l * 24 * NUP : WSP(float, WS_CV1) + (size_t)l * 24 * NIN; e.r0 = 32 * q; e.ldc = up ? NUP : NIN;
        run_gemm_w(g_wave, lds, WSP(bf16_t, WS_SHM), (const bf16_t*)(ws + WS_W + l * W_LAYER + (up ? W_UP : W_IN)), 256, up ? NUP : NIN, 1024, G - (q * 10) % G, e);
    }
    {
        PH_BEGIN
        float* MOD = WSP(float, WS_MOD); float* SSQ = WSP(float, WS_SSQ); bf16_t* AP = UP(U_AP);
        if (bid >= 32) {
        const int w = tid >> 6, lane = tid & 63;
        for (int row = (bid - 32) * 8 + w; row < MT; row += (G - 32) * 8) {
            int mb, pos, kvrow; row_info(row, mb, pos, kvrow);
            const float* xr = row < MP ? PIN(I_XP) + (size_t)row * 1024 : PIN(I_XS) + (size_t)(row - MP) * 1024;
            const float* sc1 = MOD + (size_t)mb * 6144 + 1024;
            float s = 0.f;
#pragma unroll
            for (int half = 0; half < 2; ++half) {
                const int c = half * 512 + lane * 8;
                float v[8];
#pragma unroll
                for (int q = 0; q < 2; ++q) {
                    const f32x4 x = *(const f32x4*)(xr + c + 4 * q), g = *(const f32x4*)(PIN(I_GN1) + c + 4 * q), sc = *(const f32x4*)(sc1 + c + 4 * q);
#pragma unroll
                    for (int j = 0; j < 4; ++j) { s += x[j] * x[j]; v[4 * q + j] = x[j] * g[j] * (1.f + sc[j]); }
                }
                *(u32x4*)(AP + (size_t)row * 1024 + c) = pack8(v);
            }
#pragma unroll
            for (int o = 32; o >= 1; o >>= 1) s += shx(s, lane, o);
            if (lane < 16) SSQ[(size_t)row * 16 + lane] = lane == 0 ? s : 0.f;
        }
        }
    }
    GSYNC();
    for (int l = 0; l < 2; ++l) {
#ifndef REP_P3
#define REP_P3 1
#endif
        if (l == 0) {
        for (int rep = 0; rep < REP_P3; ++rep) {
            PH_BEGIN
            EpiIn e; e.l = l; e.ws = ws; e.out = out; e.gkv = PIN(I_GKV) + l * 256; e.xl = lds + 131072;
            run_gemm_w(g_wave, lds, UP(U_AP), (const bf16_t*)(ws + WS_W + l * W_LAYER + W_IN), MT, NIN, 1024, 0, e);
            if (rep == 0 && bid >= 168) { constexpr int per_layer = 160 + 18 + 16 + 16 + 64 + 352 + 176; for (int it = bid - 168; it < per_layer; it += G - 168) TRANSPOSE_DISPATCH(1, it); }
        }
        GSYNC();
        }
#ifndef REP_P4G
#define REP_P4G 1
#endif
        for (int rep = 0; rep < REP_P4G; ++rep) {
            PH_BEGIN
            EpiQ eq; eq.ws = ws;
            run_gemm_w(g_wave, lds, UP(U_ZQ), (const bf16_t*)(ws + WS_W + l * W_LAYER + W_UQ), MT, 768, 384, 0, eq);
        }
        for (int mode = 0; mode < 2 * REP_P4G; ++mode) {
            PH_BEGIN
            EpiKV ek; ek.mode = mode & 1; ek.ws = ws;
            run_gemm_w(g_wave, lds, (mode & 1) ? WSP(bf16_t, WS_CLB) + (size_t)l * 16384 * 256 : UP(U_ZKV), (const bf16_t*)(ws + WS_W + l * W_LAYER + ((mode & 1) ? W_UKV : W_UKVG)), (mode & 1) ? 16384 : MT, 1024, 256,
                     G - ((mode & 1) ? 476 : 204) % G, ek);
        }
        {
            PH_BEGIN
#if RET_PAR
            for (int it = bid; it < 1024; it += G)
                uc_item(g_wave, lds, UP(U_RK), UP(U_RV), (float*)(U + U_UC) + (size_t)it * 4096, (it >> 7) * 2048 + 64 * (it & 31), (it >> 5) & 3);
#endif
            bf16_t* KR = UP(U_KR);
            for (int idx = bid * 512 + tid; idx < 16384 * 4; idx += G * 512) {
                const int srow = idx >> 2, c = (idx & 3) * 8;
                const float* s = PIN(I_CKR) + ((size_t)l * 16384 + srow) * 32 + c;
                const f32x4 a = *(const f32x4*)s, b = *(const f32x4*)(s + 4);
                u32x4 wv; wv.x = pk2(a[0], a[1]); wv.y = pk2(a[2], a[3]); wv.z = pk2(b[0], b[1]); wv.w = pk2(b[2], b[3]);
                *(u32x4*)(KR + (size_t)(MP + (srow >> 10) * KVS + (srow & 1023)) * 32 + c) = wv;
            }
        }
        GSYNC();
        {
            LAS int* sitem = (LAS int*)(lds + LDS_MISC);
#ifndef REP_P5
#define REP_P5 1
#endif
            for (int rep = 0; rep < REP_P5; ++rep)
            for (;;) {
                PH_BEGIN
                __syncthreads();
                if (tid == 0) *sitem = (int)atomicAdd(WSP(unsigned, WS_CTL) + 3600 + l + 2 * rep, 1u);
                __syncthreads();
                const int it = *sitem;
                if (it >= 1280) break;
                int type, b, hh, qb = 0, samp = 0, grp = 0;
#if RET_PAR
                if (it < 256) { type = 0; grp = 7 - (it >> 5); b = (it >> 2) & 7; hh = it & 3; }
#else
                if (it < 256) { if (it >= 32) continue; type = 0; grp = 7; b = (it >> 2) & 7; hh = it & 3; }
#endif
                else if (it < 384) { type = 1; samp = 1; b = (it - 256) >> 3; hh = it & 7; }
                else if (it < 448) { type = 2; samp = 1; b = (it - 384) >> 2; hh = it & 3; }
                else if (it < 512) { type = 0; samp = 1; b = (it - 448) >> 2; hh = it & 3; }
                else { const int q = it - 512, s = q % 96; qb = 7 - q / 96; if (s < 64) { type = 1; b = s >> 3; hh = s & 7; } else { type = 2; b = (s - 64) >> 2; hh = s & 3; } }
                const int kvbase = samp ? MP + b * KVS : b * 2048;
                const int qrow0 = samp ? MP + b * 64 : b * 2048 + 256 * qb;
                const int nq = samp ? 64 : 256;
                bf16_t* mixp = samp ? UP(U_UC) - (size_t)MP * 1024 : UP(U_MIX);
#ifndef NO_P5
                if (type == 1) {
                    const int w = tid >> 6;
                    mla_item(g_wave, lds, UP(U_QN), UP(U_QR), UP(U_KN), UP(U_KR), UP(U_VM), mixp, kvbase, qrow0, nq, hh, samp ? 17 : 4 * qb + 4, samp ? (w < 2 ? 17 : 0) : 4 * qb + (w >> 1) + 1);
                } else if (type == 2) {
                    sb_item(g_wave, lds, UP(U_SQ), samp ? out + O_SSK + ((size_t)l * MS + b * 64) * 256 : out + O_PSK + ((size_t)l * MP + b * 2048) * 256,
                            samp ? out + O_SSV + ((size_t)l * MS + b * 64) * 256 : out + O_PSV + ((size_t)l * MP + b * 2048) * 256, mixp, kvbase, qrow0, samp ? 1024 : 256 * qb, nq, hh,
                            samp ? PIN(I_CSK) + ((size_t)l * 16 + b) * 1024 * 256 : nullptr, samp ? PIN(I_CSV) + ((size_t)l * 16 + b) * 1024 * 256 : nullptr);
                } else {
                    const float* S0 = samp ? PIN(I_SRET) + ((size_t)(l * 16 + b) * 4 + hh) * 4096 : nullptr;
                    float* So = samp ? out + O_SS + ((size_t)(l * 16 + b) * 4 + hh) * 4096 : (grp == 7 ? out + O_PS + ((size_t)(l * 8 + b) * 4 + hh) * 4096 : nullptr);
#if RET_PAR
                    const float* UCb = samp ? nullptr : (const float*)(U + U_UC) + (size_t)((b * 4 + hh) * 32) * 4096;
                    ret_item(g_wave, lds, UP(U_RQ), UP(U_RK), UP(U_RV), UP(U_RG), PIN(I_GRET) + l * 256, mixp, samp ? MP + b * 64 : b * 2048 + 256 * grp, samp ? 1 : 4, hh, S0, So, UCb, 4 * grp);
#else
#ifndef REP_RET
#define REP_RET 1
#endif
                    for (int rr_ = 0; rr_ < REP_RET; ++rr_) {
                    ret_item(g_wave, lds, UP(U_RQ), UP(U_RK), UP(U_RV), UP(U_RG), PIN(I_GRET) + l * 256, mixp, samp ? MP + b * 64 : b * 2048, samp ? 1 : 32, hh, S0, So, nullptr, 0);
                    __syncthreads(); }
#endif
                }
#endif
            }
        }
        GSYNC();
#ifndef REP_P6
#define REP_P6 1
#endif
#ifndef REP_P9
#define REP_P9 1
#endif
        {
            PH_BEGIN
            unsigned* hand1 = WSP(unsigned, WS_CTL) + 3700 + 64 * l + 16;
            unsigned* hand2 = WSP(unsigned, WS_CTL) + 3700 + 64 * l + 32;
#define HAND_PUBLISH(p) do { asm volatile("s_waitcnt vmcnt(0)" ::: "memory"); __syncthreads(); \
                if (otid() == 0) { __builtin_amdgcn_fence(__ATOMIC_RELEASE, "agent"); asm volatile("s_waitcnt vmcnt(0)" ::: "memory"); (void)xb_add((p), 1u); } } while (0)
#define HAND_WAITN(p, n) do { if (otid() == 0) { unsigned sp_ = 0u; while (xb_ld(p) < (unsigned)(n)) { __builtin_amdgcn_s_sleep(2); if (++sp_ > (1u << 22)) break; } \
                __builtin_amdgcn_fence(__ATOMIC_ACQUIRE, "agent"); asm volatile("s_waitcnt vmcnt(0)" ::: "memory"); } __syncthreads(); } while (0)
            EpiRes e; e.xin_p = l == 0 ? PIN(I_XP) : out + O_YP; e.xin_s = l == 0 ? PIN(I_XS) : out + O_YS; e.xout = out; e.ws = ws; e.gate_off = l * 24 * 6144 + 2048;
            e.has_ap = 1; e.gn = PIN(I_GN2) + l * 1024; e.scn_off = l * 24 * 6144 + 4096;
            EpiUp eu; eu.l = l; eu.ws = ws; eu.out = out; eu.convw = PIN(I_CONVW); eu.convb = PIN(I_CONVB); eu.sconv = PIN(I_SCONV);
            const bf16_t* WOl = (const bf16_t*)(ws + WS_W + l * W_LAYER + W_O); const bf16_t* WUPl = (const bf16_t*)(ws + WS_W + l * W_LAYER + W_UP);
            run_gemm_sub(g_wave, lds, UP(U_MIX), WOl, MP, 1024, 1024, 0, G, bid, e);
            HAND_PUBLISH(hand1);
            if (bid < 16) {
                run_gemm_sub(g_wave, lds, UP(U_UC) - (size_t)MP * 1024, WOl, MS, 1024, 1024, 64, 16, bid, e);
                HAND_PUBLISH(hand2);
                HAND_WAITN(hand2, 16);
                run_gemm_win(g_wave, lds, UP(U_AP), WUPl, MS, NUP, 1024, 64, 16, bid, 0, 64, eu);
            } else {
                HAND_WAITN(hand1, G);
                run_gemm_sub(g_wave, lds, UP(U_AP), WUPl, MP, NUP, 1024, 0, G - 16, bid - 16, eu);
                if (bid >= G - 24) {
                    HAND_WAITN(hand2, 16);
                    run_gemm_win(g_wave, lds, UP(U_AP), WUPl, MS, NUP, 1024, 64, 24, bid - (G - 24), 64, 88, eu);
                }
            }
#undef HAND_PUBLISH
#undef HAND_WAITN
        }
        GSYNC();
        {
            PH_BEGIN
            EpiRes e; e.xin_p = out + O_YP; e.xin_s = out + O_YS; e.xout = out; e.ws = ws; e.gate_off = l * 24 * 6144 + 5120;
            e.has_ap = (l == 0); e.gn = PIN(I_GN1) + 1024; e.scn_off = 24 * 6144 + 1024;
            {
                pg8::StaticOrder So; So.init(MP, 1024, G, bid);
                pg8::Unit uu;
                bf16_t* B_ = UP(U_B);
                const float* HA = (const float*)(U + U_HA); const float* HB = (const float*)(U + U_HB); const float* TA = (const float*)(U + U_TA);
                const float* cw = PIN(I_CONVW) + (size_t)l * 3 * DFF; const float* cbp = PIN(I_CONVB) + (size_t)l * DFF;
                for (int iu = 0; So.next(iu, uu); ++iu) {
                    for (int task = tid; task < 4 * 2 * 352; task += 512) {
                        const int G64 = uu.pm * 4 + task / 704, rem = task % 704, rr = rem / 352, c = (rem % 352) * 8;
                        if ((G64 & 31) == 0) continue;
                        const float* t0 = TA + ((size_t)(G64 - 1) * 2) * DFF + c; const float* t1 = t0 + DFF;
                        const float* h0 = HA + ((size_t)G64 * 2) * DFF + c; const float* h1 = h0 + DFF;
                        const float* p2p = rr ? t1 : t0; const float* p1p = rr ? h0 : t1; const float* ap = rr ? h1 : h0;
                        const float* bp = HB + ((size_t)G64 * 2 + rr) * DFF + c;
                        float o[8];
#pragma unroll
                        for (int q = 0; q < 2; ++q) {
                            const f32x4 p2 = *(const f32x4*)(p2p + 4 * q), p1 = *(const f32x4*)(p1p + 4 * q), a = *(const f32x4*)(ap + 4 * q), b = *(const f32x4*)(bp + 4 * q);
                            const f32x4 w0 = *(const f32x4*)(cw + c + 4 * q), w1 = *(const f32x4*)(cw + DFF + c + 4 * q), w2 = *(const f32x4*)(cw + 2 * DFF + c + 4 * q), cb = *(const f32x4*)(cbp + c + 4 * q);
#pragma unroll
                            for (int j = 0; j < 4; ++j) o[4 * q + j] = silu(cb[j] + w0[j] * p2[j] + w1[j] * p1[j] + w2[j] * a[j]) * b[j];
                        }
                        *(u32x4*)(B_ + (size_t)(64 * G64 + rr) * DFF + c) = pack8(o);
                    }
                }
                asm volatile("s_waitcnt vmcnt(0)" ::: "memory");
                __syncthreads();
            }
            run_gemm_sub(g_wave, lds, UP(U_B), (const bf16_t*)(ws + WS_W + l * W_LAYER + W_DN), MP, 1024, DFF, 0, G, bid, e);
            if (l == 0) {
                for (int up = 0; up < 2; ++up) {
                    EpiC ec; ec.dst = up ? WSP(float, WS_CV2) + (size_t)24 * NUP : WSP(float, WS_CV1) + (size_t)24 * NIN; ec.r0 = 32 * (2 + up); ec.ldc = up ? NUP : NIN;
                    run_gemm_w(g_wave, lds, WSP(bf16_t, WS_SHM), (const bf16_t*)(ws + WS_W + W_LAYER + (up ? W_UP : W_IN)), 256, up ? NUP : NIN, 1024, G - (up ? 26 : 16), ec);
                }
            }
            asm volatile("s_waitcnt vmcnt(0)" ::: "memory");
            __syncthreads();
            if (otid() == 0) { __builtin_amdgcn_fence(__ATOMIC_RELEASE, "agent"); asm volatile("s_waitcnt vmcnt(0)" ::: "memory"); (void)xb_add(WSP(unsigned, WS_CTL) + 3700 + 64 * l + 48, 1u); }
        }
        {
            PH_BEGIN
            unsigned* hand = WSP(unsigned, WS_CTL) + 3700 + 64 * l;
#define HAND_WAIT() do { if (otid() == 0) { unsigned sp_ = 0u; while (xb_ld(hand) < 16u) { __builtin_amdgcn_s_sleep(2); if (++sp_ > (1u << 22)) break; } \
                __builtin_amdgcn_fence(__ATOMIC_ACQUIRE, "agent"); asm volatile("s_waitcnt vmcnt(0)" ::: "memory"); } __syncthreads(); } while (0)
            if (bid >= 16) {
                unsigned* handA = WSP(unsigned, WS_CTL) + 3700 + 64 * l + 48;
                if (otid() == 0) { unsigned sp_ = 0u; while (xb_ld(handA) < (unsigned)G) { __builtin_amdgcn_s_sleep(2); if (++sp_ > (1u << 22)) break; }
                    __builtin_amdgcn_fence(__ATOMIC_ACQUIRE, "agent"); asm volatile("s_waitcnt vmcnt(0)" ::: "memory"); }
                __syncthreads();
            }
            if (bid < 16) {
                EpiRes e; e.xin_p = out + O_YP; e.xin_s = out + O_YS; e.xout = out; e.ws = ws; e.gate_off = l * 24 * 6144 + 5120;
                e.has_ap = (l == 0); e.gn = PIN(I_GN1) + 1024; e.scn_off = 24 * 6144 + 1024;
                run_gemm_sub(g_wave, lds, UP(U_B), (const bf16_t*)(ws + WS_W + l * W_LAYER + W_DN), MS, 1024, DFF, 64, 16, bid, e);
                asm volatile("s_waitcnt vmcnt(0)" ::: "memory");
                __syncthreads();
                if (otid() == 0) { __builtin_amdgcn_fence(__ATOMIC_RELEASE, "agent"); asm volatile("s_waitcnt vmcnt(0)" ::: "memory"); (void)xb_add(hand, 1u); }
            } else if (l == 0) {
                EpiIn e1; e1.l = 1; e1.ws = ws; e1.out = out; e1.gkv = PIN(I_GKV) + 256; e1.xl = lds + 131072;
                run_gemm_sub(g_wave, lds, UP(U_AP), (const bf16_t*)(ws + WS_W + W_LAYER + W_IN), MP, NIN, 1024, 0, G - 16, bid - 16, e1);
                if (bid >= G - 40) {
                    HAND_WAIT();
                    run_gemm_sub(g_wave, lds, UP(U_AP), (const bf16_t*)(ws + WS_W + W_LAYER + W_IN), MS, NIN, 1024, 64, 40, bid - (G - 40), e1);
                }
            } else {
                const float* SSQ = WSP(float, WS_SSQ);
                const int w = tid >> 6, lane = tid & 63;
                const float* gf = PIN(I_GFIN);
                for (int row = (bid - 16) * 8 + w; row < MP; row += (G - 16) * 8) {
                    const float rinv = rsqrtf(sum16(SSQ + (size_t)row * 16) * (1.f / 1024.f) + EPS);
                    float* xr = out + (size_t)row * 1024;
#pragma unroll
                    for (int q = 0; q < 4; ++q) {
                        const int c = q * 256 + lane * 4;
                        f32x4 x = *(f32x4*)(xr + c); const f32x4 g = *(const f32x4*)(gf + c);
                        x = x * g * rinv; *(f32x4*)(xr + c) = x;
                    }
                }
                if (bid < 16 + MS / 8) {
                    HAND_WAIT();
                    const int row = MP + (bid - 16) * 8 + w;
                    const float rinv = rsqrtf(sum16(SSQ + (size_t)row * 16) * (1.f / 1024.f) + EPS);
                    float* xr = out + (size_t)row * 1024;
#pragma unroll
                    for (int q = 0; q < 4; ++q) {
                        const int c = q * 256 + lane * 4;
                        f32x4 x = *(f32x4*)(xr + c); const f32x4 g = *(const f32x4*)(gf + c);
                        x = x * g * rinv; *(f32x4*)(xr + c) = x;
                    }
                }
            }
#undef HAND_WAIT
        }
        if (l == 0) GSYNC();
    }
}

extern "C" void kernel_launch(void* const* d_in, const int* in_sizes, int n_in, void* d_out, int out_size, void* d_ws, size_t ws_size, hipStream_t stream) {
    static int grid = 0;
    if (grid == 0) {
        if (n_in != 26 || (size_t)out_size != O_END || ws_size < WS_END) {
            fprintf(stderr, "kernel_launch: unexpected shapes: n_in %d out %d (want %zu) ws %zu (need %zu)\n", n_in, out_size, (size_t)O_END, ws_size, (size_t)WS_END);
            grid = -1; return;
        }
        int dev = 0, cus = 0, per_cu = 0;
        hipGetDevice(&dev);
        hipDeviceGetAttribute(&cus, hipDeviceAttributeMultiprocessorCount, dev);
        hipFuncSetAttribute((const void*)mega, hipFuncAttributeMaxDynamicSharedMemorySize, LDS_BYTES);
        hipOccupancyMaxActiveBlocksPerMultiprocessor(&per_cu, (const void*)mega, 512, LDS_BYTES);
        if (per_cu < 1) { fprintf(stderr, "kernel_launch: occupancy query says %d blocks/CU\n", per_cu); grid = -1; return; }
        grid = cus * 1;
    }
    if (grid < 0) return;
    (void)hipMemsetAsync((char*)d_ws + WS_CTL, 0, 16384, stream);
    Params p{};
    for (int i = 0; i < 26; ++i) p.in[i] = (const float*)d_in[i];
    p.out = (float*)d_out; p.ws = (unsigned char*)d_ws;
    void* args[] = {&p};
    hipError_t e = hipLaunchCooperativeKernel((const void*)mega, dim3(grid), dim3(512), args, LDS_BYTES, stream);
    if (e != hipSuccess) fprintf(stderr, "cooperative launch failed: %s (grid %d)\n", hipGetErrorString(e), grid);
}
```
